# Optimizing an MI355X kernel written in HIP

```python
import math
import jax, jax.numpy as jnp
from jax import lax
import numpy as np

D_MODEL = 2048
BATCH = 1
SEQ = 8192
DEPTH = 2

HEAD_DIM = 64
MIX_WIDTH = D_MODEL
SWA_WIDTH = 3 * MIX_WIDTH // 8
SWA_HEADS = SWA_WIDTH // HEAD_DIM
SWA_KV_HEADS = SWA_HEADS // 3
SWA_GROUP = SWA_HEADS // SWA_KV_HEADS
WINDOW = 128
SWA_BLOCK = 128
REL_BUCKETS = 32
REL_MAX_DIST = 128
GLA_WIDTH = 3 * MIX_WIDTH // 8
GLA_HEADS = 4
GLA_DV = GLA_WIDTH // GLA_HEADS
GLA_DK = GLA_DV // 2
GLA_LOWRANK = 16
GLA_CHUNK = 64
GATE_NORMALIZER = 16.0
GATE_LOG_MIN = -1.0
SB_WIDTH = MIX_WIDTH - SWA_WIDTH - GLA_WIDTH
SB_HEADS = SB_WIDTH // HEAD_DIM
SB_BLOCK = 128
D_FF = 4 * D_MODEL
RMS_EPS = 1e-6
NEG_INF = -1e30

PROJ_SIZES = (
    SWA_WIDTH, SWA_KV_HEADS * HEAD_DIM, SWA_KV_HEADS * HEAD_DIM,
    GLA_HEADS * GLA_DK, GLA_HEADS * GLA_DK, GLA_WIDTH, GLA_WIDTH, GLA_LOWRANK,
    SB_WIDTH, SB_WIDTH, SB_WIDTH,
)
PROJ_WIDTH = sum(PROJ_SIZES)

kernel_name = 'hybrid_swa_gla_stickbreak_block'


def rmsnorm(x, gain, eps=RMS_EPS):
    xf = x.astype(jnp.float32)
    y = xf * lax.rsqrt(jnp.mean(xf * xf, axis=-1, keepdims=True) + eps)
    return (y * gain.astype(jnp.float32)).astype(x.dtype)


def t5_causal_bucket(dist):
    max_exact = REL_BUCKETS // 2
    is_small = dist < max_exact
    ratio = jnp.log(jnp.maximum(dist, 1).astype(jnp.float32) / max_exact) / math.log(REL_MAX_DIST / max_exact)
    large = max_exact + (ratio * (REL_BUCKETS - max_exact)).astype(jnp.int32)
    large = jnp.minimum(large, REL_BUCKETS - 1)
    return jnp.where(is_small, dist, large)


def swa_sink_attention(q, k, v, sinks, rel_bias):
    B, S = q.shape[:2]
    nb = S // SWA_BLOCK
    qb = q.reshape(B, nb, SWA_BLOCK, SWA_KV_HEADS, SWA_GROUP, HEAD_DIM)
    kb = k.reshape(B, nb, SWA_BLOCK, SWA_KV_HEADS, HEAD_DIM)
    vb = v.reshape(B, nb, SWA_BLOCK, SWA_KV_HEADS, HEAD_DIM)
    pad = ((0, 0), (1, 0), (0, 0), (0, 0), (0, 0))
    kw = jnp.concatenate([jnp.pad(kb, pad)[:, :-1], kb], axis=2)
    vw = jnp.concatenate([jnp.pad(vb, pad)[:, :-1], vb], axis=2)
    logits = jnp.einsum('bnqhgd,bnkhd->bnhgqk', qb, kw).astype(jnp.float32) * (HEAD_DIM ** -0.5)
    qpos = jnp.arange(SWA_BLOCK) + SWA_BLOCK
    kpos = jnp.arange(2 * SWA_BLOCK)
    dist = qpos[:, None] - kpos[None, :]
    in_window = (dist >= 0) & (dist < WINDOW)
    key_abs = jnp.arange(nb)[:, None] * SWA_BLOCK - SWA_BLOCK + kpos[None, :]
    mask = in_window[None, :, :] & (key_abs >= 0)[:, None, :]
    bias = rel_bias.astype(jnp.float32)[t5_causal_bucket(jnp.maximum(dist, 0))]
    bias = bias.transpose(2, 0, 1).reshape(SWA_KV_HEADS, SWA_GROUP, SWA_BLOCK, 2 * SWA_BLOCK)
    logits = jnp.where(mask[None, :, None, None], logits + bias[None, None], NEG_INF)
    sink_col = jnp.broadcast_to(
        sinks.astype(jnp.float32).reshape(1, 1, SWA_KV_HEADS, SWA_GROUP, 1, 1),
        logits.shape[:-1] + (1,))
    probs = jax.nn.softmax(jnp.concatenate([logits, sink_col], axis=-1), axis=-1)[..., :-1]
    out = jnp.einsum('bnhgqk,bnkhd->bnqhgd', probs.astype(v.dtype), vw)
    return out.reshape(B, S, SWA_HEADS * HEAD_DIM)


def gla_chunked(q, k, v, log_gate):
    B, S, H, dk = q.shape
    dv = v.shape[-1]
    n = S // GLA_CHUNK
    f32 = jnp.float32
    q = (q.astype(f32) * dk ** -0.5).reshape(B, n, GLA_CHUNK, H, dk)
    k = k.astype(f32).reshape(B, n, GLA_CHUNK, H, dk)
    v = v.astype(f32).reshape(B, n, GLA_CHUNK, H, dv)
    b = jnp.cumsum(log_gate.reshape(B, n, GLA_CHUNK, H, dk), axis=2)
    b_last = b[:, :, -1:]
    q_dec = q * jnp.exp(b)
    k_inv = k * jnp.exp(-b)
    k_end = k * jnp.exp(b_last - b)
    causal = jnp.tril(jnp.ones((GLA_CHUNK, GLA_CHUNK), dtype=bool))
    scores = jnp.where(causal, jnp.einsum('bnthk,bnshk->bnhts', q_dec, k_inv), 0.0)
    o_intra = jnp.einsum('bnhts,bnshv->bnthv', scores, v)
    d_state = jnp.einsum('bnshk,bnshv->bnhkv', k_end, v)
    decay = jnp.exp(b_last[:, :, 0])

    def step(state, inp):
        dec, ds = inp
        return dec[..., None] * state + ds, state

    init = jnp.zeros((B, H, dk, dv), f32)
    _, s_prev = lax.scan(step, init, (decay.swapaxes(0, 1), d_state.swapaxes(0, 1)))
    s_prev = s_prev.swapaxes(0, 1)
    o_inter = jnp.einsum('bnthk,bnhkv->bnthv', q_dec, s_prev)
    return (o_intra + o_inter).reshape(B, S, H, dv)


def stick_breaking_attention(q, k, v):
    B, S, H, D = q.shape
    nb = S // SB_BLOCK
    qb = q.reshape(B, nb, SB_BLOCK, H, D).swapaxes(0, 1)
    kpos = jnp.arange(S)
    scale = D ** -0.5

    def block(args):
        q_blk, i = args
        z = jnp.einsum('bqhd,bshd->bhqs', q_blk, k).astype(jnp.float32) * scale
        qpos = i * SB_BLOCK + jnp.arange(SB_BLOCK)
        strict = kpos[None, :] < qpos[:, None]
        log_beta = jax.nn.log_sigmoid(z)
        log_1m_beta = jnp.where(strict, jax.nn.log_sigmoid(-z), 0.0)
        between = lax.cumsum(log_1m_beta, axis=3, reverse=True) - log_1m_beta
        w = jnp.where(strict, jnp.exp(log_beta + between), 0.0)
        return jnp.einsum('bhqs,bshd->bqhd', w.astype(v.dtype), v)

    out = lax.map(block, (qb, jnp.arange(nb)))
    return out.swapaxes(0, 1).reshape(B, S, H * D)


def token_mixing(h, w_in, sinks, rel_bias, gla_gate_w, gla_gate_b, gla_norm,
                 swa_out_norm, sb_out_norm, w_out):
    B, S, _ = h.shape
    proj = h @ w_in
    split_at = np.cumsum(PROJ_SIZES)[:-1].tolist()
    aq, ak, av, bq, bk, bv, br, blr, cq, ck, cv = jnp.split(proj, split_at, axis=-1)
    out_a = swa_sink_attention(
        aq.reshape(B, S, SWA_HEADS, HEAD_DIM),
        ak.reshape(B, S, SWA_KV_HEADS, HEAD_DIM),
        av.reshape(B, S, SWA_KV_HEADS, HEAD_DIM), sinks, rel_bias)
    out_a = rmsnorm(out_a, swa_out_norm)
    gate_pre = (blr @ gla_gate_w + gla_gate_b).astype(jnp.float32)
    log_gate = jnp.maximum(jax.nn.log_sigmoid(gate_pre) / GATE_NORMALIZER, GATE_LOG_MIN)
    o_b = gla_chunked(
        bq.reshape(B, S, GLA_HEADS, GLA_DK),
        bk.reshape(B, S, GLA_HEADS, GLA_DK),
        bv.reshape(B, S, GLA_HEADS, GLA_DV),
        log_gate.reshape(B, S, GLA_HEADS, GLA_DK))
    o_b = rmsnorm(o_b, gla_norm).reshape(B, S, GLA_WIDTH).astype(h.dtype)
    out_b = o_b * jax.nn.silu(br)
    out_c = stick_breaking_attention(
        cq.reshape(B, S, SB_HEADS, HEAD_DIM),
        ck.reshape(B, S, SB_HEADS, HEAD_DIM),
        cv.reshape(B, S, SB_HEADS, HEAD_DIM))
    out_c = rmsnorm(out_c, sb_out_norm)
    mixed = jnp.concatenate([out_a, out_b, out_c], axis=-1)
    return mixed @ w_out


def squared_relu_mlp(h, w1, w2):
    return jnp.square(jax.nn.relu(h @ w1)) @ w2


def setup_inputs(seed: int = 0) -> dict:
    key = jax.random.key(seed)
    ks = jax.random.split(key, 15)
    f32 = jnp.float32

    def nrm(k, shape, scale):
        return jax.random.normal(k, shape, f32) * scale

    def gain(k, shape):
        return 1.0 + 0.05 * jax.random.normal(k, shape, f32)

    return {
        'x': nrm(ks[0], (BATCH, SEQ, D_MODEL), 1.0),
        'norm_mix': gain(ks[1], (DEPTH, D_MODEL)),
        'w_in': nrm(ks[2], (DEPTH, D_MODEL, PROJ_WIDTH), D_MODEL ** -0.5),
        'swa_sinks': nrm(ks[3], (DEPTH, SWA_HEADS), 0.5),
        'rel_bias': nrm(ks[4], (REL_BUCKETS, SWA_HEADS), 0.5),
        'gla_gate_w': nrm(ks[5], (DEPTH, GLA_LOWRANK, GLA_HEADS * GLA_DK), GLA_LOWRANK ** -0.5),
        'gla_gate_b': nrm(ks[6], (DEPTH, GLA_HEADS * GLA_DK), 0.1),
        'gla_norm': gain(ks[7], (DEPTH, GLA_DV)),
        'swa_out_norm': gain(ks[8], (DEPTH, SWA_WIDTH)),
        'sb_out_norm': gain(ks[9], (DEPTH, SB_WIDTH)),
        'w_out': nrm(ks[10], (DEPTH, MIX_WIDTH, D_MODEL), MIX_WIDTH ** -0.5),
        'norm_mlp': gain(ks[11], (DEPTH, D_MODEL)),
        'w_mlp_in': nrm(ks[12], (DEPTH, D_MODEL, D_FF), D_MODEL ** -0.5),
        'w_mlp_out': nrm(ks[13], (DEPTH, D_FF, D_MODEL), D_FF ** -0.5),
        'norm_final': gain(ks[14], (D_MODEL,)),
    }


def reference(x, norm_mix, w_in, swa_sinks, rel_bias, gla_gate_w, gla_gate_b, gla_norm,
              swa_out_norm, sb_out_norm, w_out, norm_mlp, w_mlp_in, w_mlp_out, norm_final):
    for l in range(DEPTH):
        h = rmsnorm(x, norm_mix[l])
        x = x + token_mixing(h, w_in[l], swa_sinks[l], rel_bias, gla_gate_w[l], gla_gate_b[l],
                             gla_norm[l], swa_out_norm[l], sb_out_norm[l], w_out[l])
        h = rmsnorm(x, norm_mlp[l])
        x = x + squared_relu_mlp(h, w_mlp_in[l], w_mlp_out[l])
    return rmsnorm(x, norm_final)
```

```cpp
#include <hip/hip_runtime.h>
#include <hip/hip_cooperative_groups.h>
#include <cstdio>
#include <cstdint>
namespace cg = cooperative_groups;
namespace pg8 {
#define PG8_LAS __attribute__((address_space(3)))
typedef unsigned short bf16_t;
typedef short bf16x8 __attribute__((ext_vector_type(8)));
typedef float f32x4 __attribute__((ext_vector_type(4)));
typedef unsigned u32x4 __attribute__((ext_vector_type(4)));
constexpr int BM = 256, BK = 64, HALF = 128, HTB = HALF * BK * 2  , STAGE_BYTES = 8 * HTB, NXCD = 8, WGM = 8;

__host__ __device__ __forceinline__ int lds_byte(int r, int c) { const int st = (r >> 4) * 2 + (c >> 5), rr = r & 15, cc = c & 31, ob = rr * 64 + cc * 2; return st * 1024 + (ob ^ (((ob >> 9) & 1) << 5)); }
__host__ __device__ __forceinline__ void stage_rc(int b, int& R, int& C) { const int st = b / 1024, sb = b % 1024, swz = sb ^ (((sb >> 9) & 1) << 5); R = (st >> 1) * 16 + swz / 64; C = (st & 1) * 32 + (swz % 64) / 2; }
__host__ __device__ __forceinline__ int perm32(int rho) { const int n = rho >> 4, i = rho & 15; return 8 * (i >> 2) + 4 * n + (i & 3); }

struct Unit { int pm, pn; };
struct Gemm { const bf16_t* A; const bf16_t* Bt; int M, N, K; };

struct StaticOrder {
    int nM, nN, nwg, G, c;
    __host__ __device__ void init(int M, int N, int G_, int c_) { nM = M / BM; nN = N / BM; nwg = nM * nN; G = G_; c = c_; }
    __host__ __device__ bool next(int i, Unit& u) const {
        const long L = (long)i * G + c; if (L >= nwg) return false;
        int wgid = (int)L; { const int q = nwg / NXCD, r = nwg % NXCD, xcd = wgid % NXCD, off = wgid / NXCD; wgid = (xcd < r ? xcd * (q + 1) : r * (q + 1) + (xcd - r) * q) + off; }
        const int nig = WGM * nN, gid = wgid / nig, fm = gid * WGM, gsz = (nM - fm) < WGM ? (nM - fm) : WGM;
        u.pm = fm + ((wgid % nig) % gsz); u.pn = (wgid % nig) / gsz; return true;
    }
    __device__ __forceinline__ void a_ready(const Unit&) const {}
    __device__ __forceinline__ void done(const Unit&) const {}
};
__device__ __forceinline__ unsigned cvt_pk_bf16(float lo, float hi) { unsigned r; asm volatile("v_cvt_pk_bf16_f32 %0, %1, %2" : "=v"(r) : "v"(lo), "v"(hi)); return r; }
typedef float f32x2 __attribute__((ext_vector_type(2)));
template <class Epi, class Sched, bool ALIGN_EPI = false, bool SP2 = false>
__device__ __forceinline__ void gemm_phase(PG8_LAS unsigned char* lds, const Gemm g, const Sched& S, const Epi& E) {
    int tid_ = threadIdx.x; asm volatile("" : "+v"(tid_));
    const int tid = tid_, wid = __builtin_amdgcn_readfirstlane(tid >> 6), lane = tid & 63, wr = wid >> 2, wc = wid & 3, fr = lane & 15, fq = lane >> 4;
    const int K = g.K, nt = K / BK;
    unsigned voffA[2], voffB[2];
#pragma unroll
    for (int i = 0; i < 2; ++i) { int R, C; stage_rc(tid * 16 + i * 8192, R, C); const int Rb = Epi::PERM ? ((R & ~31) + perm32(R & 31)) : R;
        voffA[i] = (unsigned)(R * K + C) * 2u; voffB[i] = (unsigned)(Rb * K + C) * 2u; }
    const size_t kstep = (size_t)(BK * 2);
    const size_t hstep = (size_t)HALF * K * 2;
    const size_t tstep = 2 * hstep;
    const unsigned ldsw = (unsigned)wid * 1024u;
    const int aoff = lds_byte(wr * 64 + fr, fq * 8), boff = lds_byte(wc * 32 + fr, fq * 8);
#define PG8_SA(b, h) (((b) * 2 + (h)) * HTB)
#define PG8_SB(b, h) ((4 + (b) * 2 + (h)) * HTB)
#define PG8_STAGE(bufoff, gbase, voff) do { _Pragma("unroll") for (int _i = 0; _i < 2; ++_i) \
        __builtin_amdgcn_global_load_lds((const unsigned*)((const char*)(gbase) + (voff)[_i]), (PG8_LAS unsigned*)(lds + (bufoff) + ldsw + _i * 8192), 16, 0, 0); } while (0)
#define PG8_LDA(dst, b, h) do { _Pragma("unroll") for (int m = 0; m < 4; ++m) _Pragma("unroll") for (int k = 0; k < 2; ++k) dst[m][k] = *(const PG8_LAS bf16x8*)(lds + PG8_SA(b, h) + aoff + m * 2048 + k * 1024); } while (0)
#define PG8_LDB(dst, b, h) do { _Pragma("unroll") for (int n = 0; n < 2; ++n) _Pragma("unroll") for (int k = 0; k < 2; ++k) dst[n][k] = *(const PG8_LAS bf16x8*)(lds + PG8_SB(b, h) + boff + n * 2048 + k * 1024); } while (0)
#define PG8_MMA(ai, bj, At, Bt) do { __builtin_amdgcn_s_setprio(1); _Pragma("unroll") for (int m = 0; m < 4; ++m) _Pragma("unroll") for (int n = 0; n < 2; ++n) _Pragma("unroll") for (int k = 0; k < 2; ++k) \
        acc[ai][bj][m][n] = __builtin_amdgcn_mfma_f32_16x16x32_bf16(Bt[n][k], At[m][k], acc[ai][bj][m][n], 0, 0, 0); __builtin_amdgcn_s_setprio(0); } while (0)
#define PG8_WAIT_V(n) asm volatile("s_waitcnt vmcnt(" #n ")" ::: "memory")
#define PG8_WAIT_L(n) asm volatile("s_waitcnt lgkmcnt(" #n ")" ::: "memory")
#define PG8_BAR __builtin_amdgcn_s_barrier()
#define PG8_SCHED __builtin_amdgcn_sched_barrier(0)
    Unit cur, nxt; int ui = 0;
    if (!S.next(0, cur)) return;
    f32x4 acc[2][2][4][2];
#pragma unroll
    for (int a = 0; a < 2; ++a)
#pragma unroll
        for (int b = 0; b < 2; ++b)
#pragma unroll
            for (int m = 0; m < 4; ++m)
#pragma unroll
                for (int n = 0; n < 2; ++n) acc[a][b][m][n] = (f32x4){0.f, 0.f, 0.f, 0.f};
    bf16x8 At[4][2], B0[2][2], B1[2][2];
    const char* cA = (const char*)g.A + (size_t)cur.pm * tstep; const char* cB = (const char*)g.Bt + (size_t)cur.pn * tstep;
    S.a_ready(cur);
    if constexpr (SP2) {
        PG8_STAGE(PG8_SB(0, 0), cB, voffB); PG8_STAGE(PG8_SB(0, 1), cB + hstep, voffB); PG8_STAGE(PG8_SA(0, 0), cA, voffA); PG8_STAGE(PG8_SA(0, 1), cA + hstep, voffA);
        if (wr == 1) PG8_BAR;
        PG8_WAIT_V(2); PG8_BAR;
        PG8_STAGE(PG8_SB(1, 0), cB + kstep, voffB); PG8_STAGE(PG8_SA(1, 0), cA + kstep, voffA); PG8_STAGE(PG8_SB(1, 1), cB + hstep + kstep, voffB);
        PG8_WAIT_V(6); PG8_BAR;
    } else {
        PG8_STAGE(PG8_SB(0, 0), cB, voffB); PG8_STAGE(PG8_SA(0, 0), cA, voffA); PG8_STAGE(PG8_SB(0, 1), cB + hstep, voffB); PG8_STAGE(PG8_SA(0, 1), cA + hstep, voffA);
        if (wr == 1) PG8_BAR;
        PG8_WAIT_V(4); PG8_BAR;
        PG8_STAGE(PG8_SB(1, 0), cB + kstep, voffB); PG8_STAGE(PG8_SA(1, 0), cA + kstep, voffA); PG8_STAGE(PG8_SB(1, 1), cB + hstep + kstep, voffB);
        PG8_WAIT_V(6); PG8_BAR;
    }
    for (;;) {
        const bool has_next = S.next(ui + 1, nxt);
        const char* nA = has_next ? (const char*)g.A + (size_t)nxt.pm * tstep : cA; const char* nB = has_next ? (const char*)g.Bt + (size_t)nxt.pn * tstep : cB;
        for (int t = 0; t < nt; t += 2) {
            const bool last = (t == nt - 2);
            const char* a1 = cA + (size_t)(t + 1) * kstep;
            const char* a2 = last ? nA : cA + (size_t)(t + 2) * kstep; const char* b2 = last ? nB : cB + (size_t)(t + 2) * kstep;
            const char* a3 = a2 + kstep; const char* b3 = b2 + kstep;
            if (last && has_next) S.a_ready(nxt);
            if constexpr (SP2) {
            PG8_LDB(B0, 0, 0); PG8_LDB(B1, 0, 1); PG8_SCHED; PG8_LDA(At, 0, 0); PG8_STAGE(PG8_SA(1, 1), a1 + hstep, voffA);
            PG8_WAIT_V(8); PG8_WAIT_L(0); PG8_BAR; PG8_MMA(0, 0, At, B0); PG8_MMA(0, 1, At, B1); PG8_BAR; PG8_SCHED;
            PG8_LDA(At, 0, 1); PG8_STAGE(PG8_SB(0, 0), b2, voffB); PG8_STAGE(PG8_SB(0, 1), b2 + hstep, voffB); PG8_STAGE(PG8_SA(0, 0), a2, voffA);
            PG8_WAIT_V(8); PG8_WAIT_L(0); PG8_BAR; PG8_MMA(1, 0, At, B0); PG8_MMA(1, 1, At, B1); PG8_BAR; PG8_SCHED;
            PG8_LDB(B0, 1, 0); PG8_LDB(B1, 1, 1); PG8_SCHED; PG8_LDA(At, 1, 0); PG8_STAGE(PG8_SA(0, 1), a2 + hstep, voffA);
            PG8_WAIT_V(8); PG8_WAIT_L(0); PG8_BAR; PG8_MMA(0, 0, At, B0); PG8_MMA(0, 1, At, B1); PG8_BAR; PG8_SCHED;
            PG8_LDA(At, 1, 1); PG8_STAGE(PG8_SB(1, 0), b3, voffB); PG8_STAGE(PG8_SB(1, 1), b3 + hstep, voffB); PG8_STAGE(PG8_SA(1, 0), a3, voffA);
            PG8_WAIT_V(8); PG8_WAIT_L(0); PG8_BAR; PG8_MMA(1, 0, At, B0); PG8_MMA(1, 1, At, B1); PG8_BAR; PG8_SCHED;
            } else {
            PG8_LDB(B0, 0, 0); PG8_SCHED; PG8_LDA(At, 0, 0); PG8_STAGE(PG8_SA(1, 1), a1 + hstep, voffA);
            PG8_WAIT_L(8); PG8_BAR; PG8_WAIT_L(0); PG8_MMA(0, 0, At, B0); PG8_BAR; PG8_SCHED;
            PG8_LDB(B1, 0, 1); PG8_STAGE(PG8_SB(0, 0), b2, voffB);
            PG8_BAR; PG8_WAIT_L(0); PG8_MMA(0, 1, At, B1); PG8_BAR;
            PG8_LDA(At, 0, 1); PG8_STAGE(PG8_SA(0, 0), a2, voffA);
            PG8_BAR; PG8_WAIT_L(0); PG8_MMA(1, 0, At, B0); PG8_BAR; PG8_SCHED;
            PG8_STAGE(PG8_SB(0, 1), b2 + hstep, voffB);
            PG8_WAIT_V(6); PG8_BAR; PG8_MMA(1, 1, At, B1); PG8_BAR;
            PG8_LDB(B0, 1, 0); PG8_SCHED; PG8_LDA(At, 1, 0); PG8_STAGE(PG8_SA(0, 1), a2 + hstep, voffA);
            PG8_WAIT_L(8); PG8_BAR; PG8_WAIT_L(0); PG8_MMA(0, 0, At, B0); PG8_BAR; PG8_SCHED;
            PG8_LDB(B1, 1, 1); PG8_STAGE(PG8_SB(1, 0), b3, voffB);
            PG8_BAR; PG8_WAIT_L(0); PG8_MMA(0, 1, At, B1); PG8_BAR;
            PG8_LDA(At, 1, 1); PG8_STAGE(PG8_SA(1, 0), a3, voffA);
            PG8_BAR; PG8_WAIT_L(0); PG8_MMA(1, 0, At, B0); PG8_BAR; PG8_SCHED;
            PG8_STAGE(PG8_SB(1, 1), b3 + hstep, voffB);
            PG8_WAIT_V(6); PG8_BAR; PG8_MMA(1, 1, At, B1); PG8_BAR;
            }
        }
        if constexpr (ALIGN_EPI) { if (wr == 0) PG8_BAR; }
        if constexpr (!Epi::AFTER_DRAIN) { E(acc, cur, wr, wc, fr, fq); S.done(cur); }
        if (!has_next) break;
#pragma unroll
        for (int a = 0; a < 2; ++a)
#pragma unroll
            for (int b = 0; b < 2; ++b)
#pragma unroll
                for (int m = 0; m < 4; ++m)
#pragma unroll
                    for (int n = 0; n < 2; ++n) acc[a][b][m][n] = (f32x4){0.f, 0.f, 0.f, 0.f};
        cur = nxt; cA = nA; cB = nB; ++ui;
        if constexpr (ALIGN_EPI) { if (wr == 1) PG8_BAR; }
    }
    PG8_WAIT_V(0);
    if constexpr (!ALIGN_EPI) { if (wr == 0) PG8_BAR; }
    PG8_BAR;
    if constexpr (Epi::AFTER_DRAIN) { E.fused(acc, cur, wr, wc, fr, fq, lds, wid, lane); S.done(cur); }
#undef PG8_SA
#undef PG8_SB
#undef PG8_STAGE
#undef PG8_LDA
#undef PG8_LDB
#undef PG8_MMA
#undef PG8_WAIT_V
#undef PG8_WAIT_L
#undef PG8_BAR
#undef PG8_SCHED
}
}

#define LAS __attribute__((address_space(3)))
typedef unsigned short bf16_t;
typedef float f32x4 __attribute__((ext_vector_type(4)));
typedef unsigned u32x4 __attribute__((ext_vector_type(4)));
typedef unsigned u32x2 __attribute__((ext_vector_type(2)));
constexpr int SEQ = 8192, DM = 2048, DEPTH = 2, DFF = 8192;
constexpr int PROJ_W = 5136, PROJ_P = 5376;
constexpr int C_AQ = 0, C_AK = 768, C_AV = 1024, C_BQ = 1280, C_BK = 1664, C_BV = 2048, C_BR = 2816, C_CQ = 3584, C_CK = 4096, C_CV = 4608, C_LR = 5120;
constexpr float RMS_EPS = 1e-6f;
constexpr int NWAVES = 8, NTHREADS = 512;
constexpr int LDS_BYTES = 147456;

constexpr size_t MiB = 1u << 20;
constexpr size_t WS_CTL = 0;
constexpr size_t WS_ROWSS = 1 * MiB;
constexpr size_t WS_DECAY = 3 * MiB;
constexpr size_t WS_WT = 4 * MiB;
constexpr size_t WT_IN = 0, WT_OUT = 21 * MiB, WT_1 = 29 * MiB, WT_2 = 61 * MiB, WT_LAYER = 93 * MiB;
constexpr size_t WS_XB = 190 * MiB;
constexpr size_t WS_PROJ = 222 * MiB;
constexpr size_t WS_OA = 306 * MiB;
constexpr size_t WS_OC = 330 * MiB;
constexpr size_t WS_OB = 346 * MiB;
constexpr size_t WS_DSTATE = 370 * MiB;
constexpr size_t WS_SPREV = 406 * MiB;
constexpr size_t WS_QDEC = 424 * MiB;
constexpr size_t WS_MIXED = 430 * MiB;
constexpr size_t WS_HID = 222 * MiB;
constexpr size_t WS_END = 462 * MiB;

__device__ const unsigned char T5B[128] = {0, 1, 2, 3, 4, 5, 6, 7, 8, 9, 10, 11, 12, 13, 14, 15, 16, 16, 16, 17, 17, 18, 18, 18, 19, 19, 19, 20, 20, 20, 20, 21, 21, 21, 21, 22, 22, 22, 22, 22, 23, 23, 23, 23, 23, 23, 24, 24, 24, 24, 24, 24, 25, 25, 25, 25, 25, 25, 25, 26, 26, 26, 26, 26, 26, 26, 26, 27, 27, 27, 27, 27, 27, 27, 27, 27, 27, 28, 28, 28, 28, 28, 28, 28, 28, 28, 28, 29, 29, 29, 29, 29, 29, 29, 29, 29, 29, 29, 29, 30, 30, 30, 30, 30, 30, 30, 30, 30, 30, 30, 30, 30, 30, 31, 31, 31, 31, 31, 31, 31, 31, 31, 31, 31, 31, 31, 31, 31};

__device__ __forceinline__ float bf2f(bf16_t u) { return __uint_as_float((unsigned)u << 16); }
__device__ __forceinline__ float bflo(unsigned x) { return __uint_as_float(x << 16); }
__device__ __forceinline__ float bfhi(unsigned x) { return __uint_as_float(x & 0xffff0000u); }
__device__ __forceinline__ unsigned f2bf(float f) { unsigned u = __float_as_uint(f); return (u + 0x7fffu + ((u >> 16) & 1u)) >> 16; }
__device__ __forceinline__ unsigned pk2(float lo, float hi) { return f2bf(lo) | (f2bf(hi) << 16); }
__device__ __forceinline__ float wave_sum(float v) {
#pragma unroll
    for (int o = 1; o < 64; o <<= 1) v += __shfl_xor(v, o);
    return v;
}
__device__ __forceinline__ float wave_max(float v) {
#pragma unroll
    for (int o = 1; o < 64; o <<= 1) v = fmaxf(v, __shfl_xor(v, o));
    return v;
}
__device__ __forceinline__ float wave_incl_scan(float x, int lane) {
#pragma unroll
    for (int o = 1; o < 64; o <<= 1) { const float y = __shfl_up(x, o); if (lane >= o) x += y; }
    return x;
}
__device__ __forceinline__ float softplusf(float z) { return fmaxf(z, 0.f) + log1pf(__expf(-fabsf(z))); }
#define LDS_WAIT() asm volatile("s_waitcnt lgkmcnt(0)" ::: "memory")

namespace pg8 {
template <int ACT> struct EpiScale {
    static constexpr bool PERM = true, AFTER_DRAIN = false;
    bf16_t* O; int ldc; const float* rowss;
    __device__ __forceinline__ void operator()(const f32x4 (&acc)[2][2][4][2], const Unit& u, int wr, int wc, int fr, int fq) const {
        const int row0 = u.pm * BM + wr * 64 + fr, col0 = u.pn * BM + wc * 32 + 8 * fq;
#pragma unroll
        for (int ai = 0; ai < 2; ++ai)
#pragma unroll
            for (int m = 0; m < 4; ++m) {
                const int row = row0 + ai * HALF + m * 16;
                const f32x4* pp = (const f32x4*)(rowss + (size_t)row * 32 + fq * 8);
                const f32x4 pa = pp[0], pb = pp[1];
                float s = ((pa[0] + pa[1]) + (pa[2] + pa[3])) + ((pb[0] + pb[1]) + (pb[2] + pb[3]));
                s += __shfl_xor(s, 16); s += __shfl_xor(s, 32);
                const float rstd = rsqrtf(s * (1.0f / 2048.0f) + 1e-6f);
                bf16_t* rowp = O + (size_t)row * ldc + col0;
#pragma unroll
                for (int bj = 0; bj < 2; ++bj) {
                    f32x4 v0 = acc[ai][bj][m][0] * rstd, v1 = acc[ai][bj][m][1] * rstd;
                    if (ACT == 1) {
#pragma unroll
                        for (int e = 0; e < 4; ++e) { const float a = fmaxf(v0[e], 0.f), b = fmaxf(v1[e], 0.f); v0[e] = a * a; v1[e] = b * b; }
                    }
                    u32x4 w; w.x = cvt_pk_bf16(v0[0], v0[1]); w.y = cvt_pk_bf16(v0[2], v0[3]); w.z = cvt_pk_bf16(v1[0], v1[1]); w.w = cvt_pk_bf16(v1[2], v1[3]);
                    *(u32x4*)(rowp + bj * HALF) = w;
                }
            }
    }
};
struct EpiResid {
    static constexpr bool PERM = true, AFTER_DRAIN = false;
    const float* base; float* out; bf16_t* xb; float* rowss;
    __device__ __forceinline__ void operator()(const f32x4 (&acc)[2][2][4][2], const Unit& u, int wr, int wc, int fr, int fq) const {
        const int row0 = u.pm * BM + wr * 64 + fr, col0 = u.pn * BM + wc * 32 + 8 * fq;
#pragma unroll
        for (int ai = 0; ai < 2; ++ai)
#pragma unroll
            for (int m = 0; m < 4; ++m) {
                const int row = row0 + ai * HALF + m * 16;
                const size_t off = (size_t)row * 2048 + col0;
                float ss = 0.f;
#pragma unroll
                for (int bj = 0; bj < 2; ++bj) {
                    f32x4 o0 = *(const f32x4*)(base + off + bj * HALF), o1 = *(const f32x4*)(base + off + bj * HALF + 4);
                    o0 += acc[ai][bj][m][0]; o1 += acc[ai][bj][m][1];
                    *(f32x4*)(out + off + bj * HALF) = o0; *(f32x4*)(out + off + bj * HALF + 4) = o1;
                    ss += ((o0[0] * o0[0] + o0[1] * o0[1]) + (o0[2] * o0[2] + o0[3] * o0[3])) + ((o1[0] * o1[0] + o1[1] * o1[1]) + (o1[2] * o1[2] + o1[3] * o1[3]));
                    u32x4 w; w.x = cvt_pk_bf16(o0[0], o0[1]); w.y = cvt_pk_bf16(o0[2], o0[3]); w.z = cvt_pk_bf16(o1[0], o1[1]); w.w = cvt_pk_bf16(o1[2], o1[3]);
                    *(u32x4*)(xb + off + bj * HALF) = w;
                }
                ss += __shfl_xor(ss, 16); ss += __shfl_xor(ss, 32);
                if (fq == 0) rowss[(size_t)row * 32 + u.pn * 4 + wc] = ss;
                if (m & 1) asm volatile("" ::: "memory");
            }
    }
};
}

__device__ __forceinline__ void p0_transpose_item(const float* __restrict__ W, int K, int N, const float* __restrict__ gain, bf16_t* __restrict__ WT, int kind, LAS float* scr, int item, int lane) {
    const int nblk = (kind == 1) ? (PROJ_P / 64) : (N / 64);
    const int kb = item / nblk, nb = item % nblk, k0 = 64 * kb, n0 = 64 * nb;
    int src0 = n0, nvalid = 64;
    if (kind == 1) { if (n0 < 3584) { src0 = n0; } else if (n0 < 5120) { src0 = n0 + 16; } else if (n0 == 5120) { src0 = 3584; nvalid = 16; } else { src0 = 0; nvalid = 0; } }
    const int c4 = (lane & 15) * 4;
#pragma unroll 4
    for (int i = 0; i < 16; ++i) {
        const int kk = 4 * i + (lane >> 4);
        f32x4 v = (f32x4){0.f, 0.f, 0.f, 0.f};
        if (c4 < nvalid) v = *(const f32x4*)(W + (size_t)(k0 + kk) * N + src0 + c4);
        const float g = gain ? gain[k0 + kk] : 1.0f;
        LAS float* d = scr + kk * 65 + c4;
        d[0] = v[0] * g; d[1] = v[1] * g; d[2] = v[2] * g; d[3] = v[3] * g;
    }
    LDS_WAIT();
    const int c = lane & 7;
#pragma unroll
    for (int j = 0; j < 8; ++j) {
        const int n = 8 * j + (lane >> 3);
        const LAS float* s = scr + (8 * c) * 65 + n;
        u32x4 o; o.x = pk2(s[0 * 65], s[1 * 65]); o.y = pk2(s[2 * 65], s[3 * 65]); o.z = pk2(s[4 * 65], s[5 * 65]); o.w = pk2(s[6 * 65], s[7 * 65]);
        *(u32x4*)(WT + (size_t)(n0 + n) * K + k0 + 8 * c) = o;
    }
    LDS_WAIT();
}

__device__ __forceinline__ void swa_naive_item(const bf16_t* __restrict__ proj, const float* __restrict__ sinks, const float* __restrict__ relb, float* __restrict__ Oa, int t, int hq, LAS float* qs, int lane) {
    const int hk = hq / 3;
    LDS_WAIT();
    qs[lane] = bf2f(proj[(size_t)t * PROJ_P + C_AQ + hq * 64 + lane]);
    LDS_WAIT();
    float logit[2];
#pragma unroll
    for (int e = 0; e < 2; ++e) {
        const int dist = lane + 64 * e, s = t - dist;
        float acc = 0.f;
        if (s >= 0) {
            const u32x4* kr = (const u32x4*)(proj + (size_t)s * PROJ_P + C_AK + hk * 64);
#pragma unroll
            for (int c = 0; c < 8; ++c) {
                const u32x4 kv = kr[c];
                const f32x4 a = *(const LAS f32x4*)(qs + 8 * c), b = *(const LAS f32x4*)(qs + 8 * c + 4);
                acc += bflo(kv.x) * a[0] + bfhi(kv.x) * a[1] + bflo(kv.y) * a[2] + bfhi(kv.y) * a[3] + bflo(kv.z) * b[0] + bfhi(kv.z) * b[1] + bflo(kv.w) * b[2] + bfhi(kv.w) * b[3];
            }
            logit[e] = acc * 0.125f + relb[(int)T5B[dist] * 12 + hq];
        } else logit[e] = -1e30f;
    }
    const float sink = sinks[hq];
    float m = wave_max(fmaxf(logit[0], logit[1])); m = fmaxf(m, sink);
    const float e0 = (t - lane >= 0) ? __expf(logit[0] - m) : 0.f, e1 = (t - lane - 64 >= 0) ? __expf(logit[1] - m) : 0.f;
    const float den = wave_sum(e0 + e1) + __expf(sink - m);
    const float p0 = e0 / den, p1 = e1 / den;
    float o = 0.f;
    const bf16_t* vcol = proj + C_AV + hk * 64 + lane;
    for (int i = 0; i < 64; ++i) { const float pi = __shfl(p0, i); const int s = t - i; if (s >= 0) o += pi * bf2f(vcol[(size_t)s * PROJ_P]); }
    for (int i = 0; i < 64; ++i) { const float pi = __shfl(p1, i); const int s = t - 64 - i; if (s >= 0) o += pi * bf2f(vcol[(size_t)s * PROJ_P]); }
    Oa[(size_t)t * 768 + hq * 64 + lane] = o;
}
__device__ __forceinline__ void sb_naive_item(const bf16_t* __restrict__ proj, float* __restrict__ Oc, int t, int h, LAS float* qs, int lane) {
    LDS_WAIT();
    qs[lane] = bf2f(proj[(size_t)t * PROJ_P + C_CQ + h * 64 + lane]);
    LDS_WAIT();
    float R = 0.f, o = 0.f;
    const bf16_t* vcol = proj + C_CV + h * 64 + lane;
    for (int s_hi = t - 1; s_hi >= 0; s_hi -= 64) {
        const int s = s_hi - lane;
        float z = 0.f, L = 0.f;
        if (s >= 0) {
            const u32x4* kr = (const u32x4*)(proj + (size_t)s * PROJ_P + C_CK + h * 64);
            float acc = 0.f;
#pragma unroll
            for (int c = 0; c < 8; ++c) {
                const u32x4 kv = kr[c];
                const f32x4 a = *(const LAS f32x4*)(qs + 8 * c), b = *(const LAS f32x4*)(qs + 8 * c + 4);
                acc += bflo(kv.x) * a[0] + bfhi(kv.x) * a[1] + bflo(kv.y) * a[2] + bfhi(kv.y) * a[3] + bflo(kv.z) * b[0] + bfhi(kv.z) * b[1] + bflo(kv.w) * b[2] + bfhi(kv.w) * b[3];
            }
            z = acc * 0.125f; L = -softplusf(z);
        }
        const float C = R + wave_incl_scan(L, lane);
        const float w = (s >= 0) ? __expf(z + C) : 0.f;
        R = __shfl(C, 63);
        const int nk = (s_hi + 1 < 64) ? (s_hi + 1) : 64;
        for (int i = 0; i < nk; ++i) { const float wi = __shfl(w, i); o += wi * bf2f(vcol[(size_t)(s_hi - i) * PROJ_P]); }
        if (R < -105.0f) break;
    }
    Oc[(size_t)t * 512 + h * 64 + lane] = o;
}
__device__ __forceinline__ void gla_seq_item(const bf16_t* __restrict__ proj, const float* __restrict__ lgate, float* __restrict__ Ob, int h, int j, int lane) {
    float s0 = 0.f, s1 = 0.f;
    const bool two = lane < 32;
    const int kA = h * 96 + lane, kB = h * 96 + 64 + (lane & 31);
    for (int t0 = 0; t0 < SEQ; t0 += 8) {
        float g0[8], k0[8], q0[8], g1[8], k1[8], q1[8], vv[8];
#pragma unroll
        for (int u = 0; u < 8; ++u) {
            const bf16_t* row = proj + (size_t)(t0 + u) * PROJ_P; const float* lg = lgate + (size_t)(t0 + u) * 384;
            g0[u] = lg[kA]; k0[u] = bf2f(row[C_BK + kA]); q0[u] = bf2f(row[C_BQ + kA]);
            g1[u] = lg[kB]; k1[u] = bf2f(row[C_BK + kB]); q1[u] = bf2f(row[C_BQ + kB]);
            vv[u] = bf2f(row[C_BV + h * 192 + j]);
        }
#pragma unroll
        for (int u = 0; u < 8; ++u) {
            s0 = __expf(g0[u]) * s0 + k0[u] * vv[u];
            s1 = __expf(g1[u]) * s1 + k1[u] * vv[u];
            float a = q0[u] * s0 + (two ? q1[u] * s1 : 0.f);
            a = wave_sum(a);
            if (lane == 0) Ob[(size_t)(t0 + u) * 768 + h * 192 + j] = a * 0.10206207261596577f;
        }
    }
}
__device__ __forceinline__ void norm_mixed_row(const float* __restrict__ Oa, const float* __restrict__ Ob, const float* __restrict__ Oc, const bf16_t* __restrict__ proj,
                                               const float* __restrict__ gA, const float* __restrict__ gB, const float* __restrict__ gC, bf16_t* __restrict__ mixed, int t, int lane) {
    bf16_t* mrow = mixed + (size_t)t * 2048;
    {
        float a[12], ss = 0.f;
#pragma unroll
        for (int i = 0; i < 12; ++i) { a[i] = Oa[(size_t)t * 768 + lane + 64 * i]; ss += a[i] * a[i]; }
        const float r = rsqrtf(wave_sum(ss) * (1.0f / 768.0f) + RMS_EPS);
#pragma unroll
        for (int i = 0; i < 12; ++i) mrow[lane + 64 * i] = (bf16_t)f2bf(a[i] * r * gA[lane + 64 * i]);
    }
#pragma unroll
    for (int h = 0; h < 4; ++h) {
        float b[3], ss = 0.f;
#pragma unroll
        for (int i = 0; i < 3; ++i) { b[i] = Ob[(size_t)t * 768 + h * 192 + lane + 64 * i]; ss += b[i] * b[i]; }
        const float r = rsqrtf(wave_sum(ss) * (1.0f / 192.0f) + RMS_EPS);
#pragma unroll
        for (int i = 0; i < 3; ++i) {
            const int c = lane + 64 * i;
            const float br = bf2f(proj[(size_t)t * PROJ_P + C_BR + h * 192 + c]);
            const float y = b[i] * r * gB[c] * (br / (1.0f + __expf(-br)));
            mrow[768 + h * 192 + c] = (bf16_t)f2bf(y);
        }
    }
    {
        float a[8], ss = 0.f;
#pragma unroll
        for (int i = 0; i < 8; ++i) { a[i] = Oc[(size_t)t * 512 + lane + 64 * i]; ss += a[i] * a[i]; }
        const float r = rsqrtf(wave_sum(ss) * (1.0f / 512.0f) + RMS_EPS);
#pragma unroll
        for (int i = 0; i < 8; ++i) mrow[1536 + lane + 64 * i] = (bf16_t)f2bf(a[i] * r * gC[lane + 64 * i]);
    }
}

#ifndef PH_MASK
#define PH_MASK 0x1ff
#endif
#define HAS(k) (((PH_MASK) >> (k)) & 1)
struct Params { const float* in[15]; float* out; unsigned char* ws; int ph_lo, ph_hi; };
constexpr int N_PHASES = 16;

__global__ void __launch_bounds__(NTHREADS, 2) mega(Params p) {
    extern __shared__ __attribute__((aligned(16))) unsigned char lds_raw[];
    LAS unsigned char* lds = (LAS unsigned char*)lds_raw;
    cg::grid_group grid = cg::this_grid();
    const int G = gridDim.x;
    unsigned char* ws = p.ws;
    const float* x_in = p.in[0];
    float* xres = p.out;
    bf16_t* xb = (bf16_t*)(ws + WS_XB);
    float* rowss = (float*)(ws + WS_ROWSS);
    bf16_t* proj = (bf16_t*)(ws + WS_PROJ);
    float* Oa = (float*)(ws + WS_OA); float* Ob = (float*)(ws + WS_OB); float* Oc = (float*)(ws + WS_OC);
    float* lgate = (float*)(ws + WS_DSTATE);
    bf16_t* mixed = (bf16_t*)(ws + WS_MIXED);
    bf16_t* hid = (bf16_t*)(ws + WS_HID);
#define IN(k) (p.ph_lo <= (k) && (k) < p.ph_hi)
#define SYNC(k) do { if (IN(k) && IN((k) + 1)) grid.sync(); } while (0)
#define PHASE_IDS() int tid = threadIdx.x; asm volatile("" : "+v"(tid)); const int lane = tid & 63, wave = __builtin_amdgcn_readfirstlane(tid >> 6), gw = blockIdx.x * NWAVES + wave, NGW = G * NWAVES; (void)lane; (void)gw; (void)NGW

    if (HAS(0) && IN(0)) {
        PHASE_IDS();
        LAS float* scr = (LAS float*)(lds + wave * 16640);
        constexpr int I_IN = 32 * (PROJ_P / 64), I_OUT = 32 * 32, I_1 = 32 * 128, I_2 = 128 * 32, I_L = I_IN + I_OUT + I_1 + I_2;
        for (int it = gw; it < DEPTH * I_L; it += NGW) {
            const int l = it / I_L; int r = it % I_L;
            unsigned char* wt = ws + WS_WT + (size_t)l * WT_LAYER;
            if (r < I_IN) { p0_transpose_item(p.in[2] + (size_t)l * DM * PROJ_W, DM, PROJ_W, p.in[1] + l * DM, (bf16_t*)(wt + WT_IN), 1, scr, r, lane); continue; } r -= I_IN;
            if (r < I_OUT) { p0_transpose_item(p.in[10] + (size_t)l * DM * DM, DM, DM, nullptr, (bf16_t*)(wt + WT_OUT), 0, scr, r, lane); continue; } r -= I_OUT;
            if (r < I_1) { p0_transpose_item(p.in[12] + (size_t)l * DM * DFF, DM, DFF, p.in[11] + l * DM, (bf16_t*)(wt + WT_1), 0, scr, r, lane); continue; } r -= I_1;
            p0_transpose_item(p.in[13] + (size_t)l * DFF * DM, DFF, DM, nullptr, (bf16_t*)(wt + WT_2), 0, scr, r, lane);
        }
        for (int m = gw; m < SEQ; m += NGW) {
            const f32x4* xr = (const f32x4*)(x_in + (size_t)m * DM) + lane;
            f32x4 v[8]; float ss = 0.f;
#pragma unroll
            for (int j = 0; j < 8; ++j) { v[j] = xr[64 * j]; ss += (v[j][0] * v[j][0] + v[j][1] * v[j][1]) + (v[j][2] * v[j][2] + v[j][3] * v[j][3]); }
            ss = wave_sum(ss);
            u32x2* o8 = (u32x2*)(xb + (size_t)m * DM) + lane;
#pragma unroll
            for (int j = 0; j < 8; ++j) { u32x2 w; w.x = pk2(v[j][0], v[j][1]); w.y = pk2(v[j][2], v[j][3]); o8[64 * j] = w; }
            if (lane < 32) rowss[(size_t)m * 32 + lane] = (lane == 0) ? ss : 0.f;
        }
    }
    SYNC(0);
    for (int l = 0; l < DEPTH; ++l) {
        const int pb = 1 + 7 * l;
        unsigned char* wt = ws + WS_WT + (size_t)l * WT_LAYER;
        if (HAS(1) && IN(pb + 0)) {
            pg8::Gemm g{xb, (const bf16_t*)(wt + WT_IN), SEQ, PROJ_P, DM}; pg8::StaticOrder S; S.init(SEQ, PROJ_P, G, (int)blockIdx.x);
            pg8::EpiScale<0> E{proj, PROJ_P, rowss};
            pg8::gemm_phase<pg8::EpiScale<0>, pg8::StaticOrder, true, true>(lds, g, S, E);
        }
        SYNC(pb + 0);
        if (HAS(2) && IN(pb + 1)) {
            PHASE_IDS();
            const float* gwt = p.in[5] + (size_t)l * 16 * 384; const float* gbs = p.in[6] + l * 384;
            for (int idx = blockIdx.x * NTHREADS + tid; idx < SEQ * 384; idx += G * NTHREADS) {
                const int t = idx / 384, c = idx % 384;
                const bf16_t* lr = proj + (size_t)t * PROJ_P + C_LR;
                float gp = gbs[c];
#pragma unroll
                for (int r = 0; r < 16; ++r) gp += bf2f(lr[r]) * gwt[r * 384 + c];
                const float ls = fminf(gp, 0.f) - log1pf(__expf(-fabsf(gp)));
                lgate[idx] = fmaxf(ls * (1.0f / 16.0f), -1.0f);
            }
            LAS float* qs = (LAS float*)lds + wave * 64;
            const float* sinks = p.in[3] + l * 12; const float* relb = p.in[4];
            for (int it = gw; it < SEQ * 12; it += NGW) swa_naive_item(proj, sinks, relb, Oa, it / 12, it % 12, qs, lane);
            for (int it = gw; it < SEQ * 8; it += NGW) sb_naive_item(proj, Oc, it / 8, it % 8, qs, lane);
        }
        SYNC(pb + 1);
        if (HAS(3) && IN(pb + 2)) {
            PHASE_IDS();
            for (int it = gw; it < 4 * 192; it += NGW) gla_seq_item(proj, lgate, Ob, it / 192, it % 192, lane);
        }
        SYNC(pb + 2);
        if (HAS(4) && IN(pb + 3)) {
            PHASE_IDS();
            const float* gA = p.in[8] + l * 768; const float* gB = p.in[7] + l * 192; const float* gC = p.in[9] + l * 512;
            for (int t = gw; t < SEQ; t += NGW) norm_mixed_row(Oa, Ob, Oc, proj, gA, gB, gC, mixed, t, lane);
        }
        SYNC(pb + 3);
        if (HAS(5) && IN(pb + 4)) {
            pg8::Gemm g{mixed, (const bf16_t*)(wt + WT_OUT), SEQ, DM, DM}; pg8::StaticOrder S; S.init(SEQ, DM, G, (int)blockIdx.x);
            pg8::EpiResid E{l == 0 ? x_in : xres, xres, xb, rowss};
            pg8::gemm_phase<pg8::EpiResid, pg8::StaticOrder, true, true>(lds, g, S, E);
        }
        SYNC(pb + 4);
        if (HAS(6) && IN(pb + 5)) {
            pg8::Gemm g{xb, (const bf16_t*)(wt + WT_1), SEQ, DFF, DM}; pg8::StaticOrder S; S.init(SEQ, DFF, G, (int)blockIdx.x);
            pg8::EpiScale<1> E{hid, DFF, rowss};
            pg8::gemm_phase<pg8::EpiScale<1>, pg8::StaticOrder, true, true>(lds, g, S, E);
        }
        SYNC(pb + 5);
        if (HAS(7) && IN(pb + 6)) {
            pg8::Gemm g{hid, (const bf16_t*)(wt + WT_2), SEQ, DM, DFF}; pg8::StaticOrder S; S.init(SEQ, DM, G, (int)blockIdx.x);
            pg8::EpiResid E{xres, xres, xb, rowss};
            pg8::gemm_phase<pg8::EpiResid, pg8::StaticOrder, true, true>(lds, g, S, E);
        }
        SYNC(pb + 6);
    }
    if (HAS(8) && IN(N_PHASES - 1)) {
        PHASE_IDS();
        const float* gF = p.in[14];
        for (int m = gw; m < SEQ; m += NGW) {
            const float part = (lane < 32) ? rowss[(size_t)m * 32 + lane] : 0.f;
            const float rstd = rsqrtf(wave_sum(part) * (1.0f / 2048.0f) + RMS_EPS);
            f32x4* xr = (f32x4*)(xres + (size_t)m * DM) + lane;
            const f32x4* gr = (const f32x4*)gF + lane;
#pragma unroll
            for (int j = 0; j < 8; ++j) { f32x4 v = xr[64 * j]; const f32x4 g = gr[64 * j]; v = v * rstd * g; xr[64 * j] = v; }
        }
    }
}

#ifndef MK_N_LAUNCHES
#define MK_N_LAUNCHES 16
#endif
extern "C" void kernel_launch(void* const* d_in, const int* in_sizes, int n_in, void* d_out, int out_size, void* d_ws, size_t ws_size, hipStream_t stream) {
    static int grid = 0;
    if (grid == 0) {
        if (n_in != 15 || out_size != SEQ * DM || ws_size < WS_END) { fprintf(stderr, "kernel_launch: unexpected shapes (n_in %d out %d ws %zu)\n", n_in, out_size, ws_size); grid = -1; return; }
        int dev = 0, cus = 0, per_cu = 0;
        hipGetDevice(&dev);
        hipDeviceGetAttribute(&cus, hipDeviceAttributeMultiprocessorCount, dev);
        hipFuncSetAttribute((const void*)mega, hipFuncAttributeMaxDynamicSharedMemorySize, LDS_BYTES);
        hipOccupancyMaxActiveBlocksPerMultiprocessor(&per_cu, (const void*)mega, NTHREADS, LDS_BYTES);
        if (per_cu < 1) { fprintf(stderr, "kernel_launch: occupancy query says %d blocks/CU\n", per_cu); per_cu = 1; }
        (void)hipGetLastError();
        grid = cus * 1;
    }
    if (grid < 0) return;
    Params p{};
    for (int i = 0; i < 15; ++i) p.in[i] = (const float*)d_in[i];
    p.out = (float*)d_out; p.ws = (unsigned char*)d_ws;
    if (MK_N_LAUNCHES == 1) {
        p.ph_lo = 0; p.ph_hi = N_PHASES;
        void* args[] = {&p};
        hipError_t e = hipLaunchCooperativeKernel((const void*)mega, dim3(grid), dim3(NTHREADS), args, LDS_BYTES, stream);
        if (e != hipSuccess) fprintf(stderr, "cooperative launch failed: %s (grid %d)\n", hipGetErrorString(e), grid);
    } else {
        for (int ph = 0; ph < N_PHASES; ++ph) {
            p.ph_lo = ph; p.ph_hi = ph + 1;
            hipLaunchKernelGGL(mega, dim3(grid), dim3(NTHREADS), LDS_BYTES, stream, p);
        }
    }
}
```

```cpp
#include <hip/hip_runtime.h>
#include <hip/hip_cooperative_groups.h>
#include <cstdio>
#include <cstdint>
namespace cg = cooperative_groups;
namespace pg8 {
#define PG8_LAS __attribute__((address_space(3)))
typedef unsigned short bf16_t;
typedef short bf16x8 __attribute__((ext_vector_type(8)));
typedef float f32x4 __attribute__((ext_vector_type(4)));
typedef unsigned u32x4 __attribute__((ext_vector_type(4)));
constexpr int BM = 256, BK = 64, HALF = 128, HTB = HALF * BK * 2  , STAGE_BYTES = 8 * HTB, NXCD = 8, WGM = 8;

__host__ __device__ __forceinline__ int lds_byte(int r, int c) { const int st = (r >> 4) * 2 + (c >> 5), rr = r & 15, cc = c & 31, ob = rr * 64 + cc * 2; return st * 1024 + (ob ^ (((ob >> 9) & 1) << 5)); }
__host__ __device__ __forceinline__ void stage_rc(int b, int& R, int& C) { const int st = b / 1024, sb = b % 1024, swz = sb ^ (((sb >> 9) & 1) << 5); R = (st >> 1) * 16 + swz / 64; C = (st & 1) * 32 + (swz % 64) / 2; }
__host__ __device__ __forceinline__ int perm32(int rho) { const int n = rho >> 4, i = rho & 15; return 8 * (i >> 2) + 4 * n + (i & 3); }

struct Unit { int pm, pn; };
struct Gemm { const bf16_t* A; const bf16_t* Bt; int M, N, K; };

struct StaticOrder {
    int nM, nN, nwg, G, c;
    __host__ __device__ void init(int M, int N, int G_, int c_) { nM = M / BM; nN = N / BM; nwg = nM * nN; G = G_; c = c_; }
    __host__ __device__ bool next(int i, Unit& u) const {
        const long L = (long)i * G + c; if (L >= nwg) return false;
        int wgid = (int)L; { const int q = nwg / NXCD, r = nwg % NXCD, xcd = wgid % NXCD, off = wgid / NXCD; wgid = (xcd < r ? xcd * (q + 1) : r * (q + 1) + (xcd - r) * q) + off; }
        const int nig = WGM * nN, gid = wgid / nig, fm = gid * WGM, gsz = (nM - fm) < WGM ? (nM - fm) : WGM;
        u.pm = fm + ((wgid % nig) % gsz); u.pn = (wgid % nig) / gsz; return true;
    }
    __device__ __forceinline__ void a_ready(const Unit&) const {}
    __device__ __forceinline__ void done(const Unit&) const {}
};
__device__ __forceinline__ unsigned cvt_pk_bf16(float lo, float hi) { unsigned r; asm volatile("v_cvt_pk_bf16_f32 %0, %1, %2" : "=v"(r) : "v"(lo), "v"(hi)); return r; }
typedef float f32x2 __attribute__((ext_vector_type(2)));
template <class Epi, class Sched, bool ALIGN_EPI = false, bool SP2 = false>
__device__ __forceinline__ void gemm_phase(PG8_LAS unsigned char* lds, const Gemm g, const Sched& S, const Epi& E) {
    int tid_ = threadIdx.x; asm volatile("" : "+v"(tid_));
    const int tid = tid_, wid = __builtin_amdgcn_readfirstlane(tid >> 6), lane = tid & 63, wr = wid >> 2, wc = wid & 3, fr = lane & 15, fq = lane >> 4;
    const int K = g.K, nt = K / BK;
    unsigned voffA[2], voffB[2];
#pragma unroll
    for (int i = 0; i < 2; ++i) { int R, C; stage_rc(tid * 16 + i * 8192, R, C); const int Rb = Epi::PERM ? ((R & ~31) + perm32(R & 31)) : R;
        voffA[i] = (unsigned)(R * K + C) * 2u; voffB[i] = (unsigned)(Rb * K + C) * 2u; }
    const size_t kstep = (size_t)(BK * 2);
    const size_t hstep = (size_t)HALF * K * 2;
    const size_t tstep = 2 * hstep;
    const unsigned ldsw = (unsigned)wid * 1024u;
    const int aoff = lds_byte(wr * 64 + fr, fq * 8), boff = lds_byte(wc * 32 + fr, fq * 8);
#define PG8_SA(b, h) (((b) * 2 + (h)) * HTB)
#define PG8_SB(b, h) ((4 + (b) * 2 + (h)) * HTB)
#define PG8_STAGE(bufoff, gbase, voff) do { _Pragma("unroll") for (int _i = 0; _i < 2; ++_i) \
        __builtin_amdgcn_global_load_lds((const unsigned*)((const char*)(gbase) + (voff)[_i]), (PG8_LAS unsigned*)(lds + (bufoff) + ldsw + _i * 8192), 16, 0, 0); } while (0)
#define PG8_LDA(dst, b, h) do { _Pragma("unroll") for (int m = 0; m < 4; ++m) _Pragma("unroll") for (int k = 0; k < 2; ++k) dst[m][k] = *(const PG8_LAS bf16x8*)(lds + PG8_SA(b, h) + aoff + m * 2048 + k * 1024); } while (0)
#define PG8_LDB(dst, b, h) do { _Pragma("unroll") for (int n = 0; n < 2; ++n) _Pragma("unroll") for (int k = 0; k < 2; ++k) dst[n][k] = *(const PG8_LAS bf16x8*)(lds + PG8_SB(b, h) + boff + n * 2048 + k * 1024); } while (0)
#define PG8_MMA(ai, bj, At, Bt) do { __builtin_amdgcn_s_setprio(1); _Pragma("unroll") for (int m = 0; m < 4; ++m) _Pragma("unroll") for (int n = 0; n < 2; ++n) _Pragma("unroll") for (int k = 0; k < 2; ++k) \
        acc[ai][bj][m][n] = __builtin_amdgcn_mfma_f32_16x16x32_bf16(Bt[n][k], At[m][k], acc[ai][bj][m][n], 0, 0, 0); __builtin_amdgcn_s_setprio(0); } while (0)
#define PG8_WAIT_V(n) asm volatile("s_waitcnt vmcnt(" #n ")" ::: "memory")
#define PG8_WAIT_L(n) asm volatile("s_waitcnt lgkmcnt(" #n ")" ::: "memory")
#define PG8_BAR __builtin_amdgcn_s_barrier()
#define PG8_SCHED __builtin_amdgcn_sched_barrier(0)
    Unit cur, nxt; int ui = 0;
    if (!S.next(0, cur)) return;
    f32x4 acc[2][2][4][2];
#pragma unroll
    for (int a = 0; a < 2; ++a)
#pragma unroll
        for (int b = 0; b < 2; ++b)
#pragma unroll
            for (int m = 0; m < 4; ++m)
#pragma unroll
                for (int n = 0; n < 2; ++n) acc[a][b][m][n] = (f32x4){0.f, 0.f, 0.f, 0.f};
    bf16x8 At[4][2], B0[2][2], B1[2][2];
    const char* cA = (const char*)g.A + (size_t)cur.pm * tstep; const char* cB = (const char*)g.Bt + (size_t)cur.pn * tstep;
    S.a_ready(cur);
    if constexpr (SP2) {
        PG8_STAGE(PG8_SB(0, 0), cB, voffB); PG8_STAGE(PG8_SB(0, 1), cB + hstep, voffB); PG8_STAGE(PG8_SA(0, 0), cA, voffA); PG8_STAGE(PG8_SA(0, 1), cA + hstep, voffA);
        if (wr == 1) PG8_BAR;
        PG8_WAIT_V(2); PG8_BAR;
        PG8_STAGE(PG8_SB(1, 0), cB + kstep, voffB); PG8_STAGE(PG8_SA(1, 0), cA + kstep, voffA); PG8_STAGE(PG8_SB(1, 1), cB + hstep + kstep, voffB);
        PG8_WAIT_V(6); PG8_BAR;
    } else {
        PG8_STAGE(PG8_SB(0, 0), cB, voffB); PG8_STAGE(PG8_SA(0, 0), cA, voffA); PG8_STAGE(PG8_SB(0, 1), cB + hstep, voffB); PG8_STAGE(PG8_SA(0, 1), cA + hstep, voffA);
        if (wr == 1) PG8_BAR;
        PG8_WAIT_V(4); PG8_BAR;
        PG8_STAGE(PG8_SB(1, 0), cB + kstep, voffB); PG8_STAGE(PG8_SA(1, 0), cA + kstep, voffA); PG8_STAGE(PG8_SB(1, 1), cB + hstep + kstep, voffB);
        PG8_WAIT_V(6); PG8_BAR;
    }
    for (;;) {
        const bool has_next = S.next(ui + 1, nxt);
        const char* nA = has_next ? (const char*)g.A + (size_t)nxt.pm * tstep : cA; const char* nB = has_next ? (const char*)g.Bt + (size_t)nxt.pn * tstep : cB;
        for (int t = 0; t < nt; t += 2) {
            const bool last = (t == nt - 2);
            const char* a1 = cA + (size_t)(t + 1) * kstep;
            const char* a2 = last ? nA : cA + (size_t)(t + 2) * kstep; const char* b2 = last ? nB : cB + (size_t)(t + 2) * kstep;
            const char* a3 = a2 + kstep; const char* b3 = b2 + kstep;
            if (last && has_next) S.a_ready(nxt);
            if constexpr (SP2) {
            PG8_LDB(B0, 0, 0); PG8_LDB(B1, 0, 1); PG8_SCHED; PG8_LDA(At, 0, 0); PG8_STAGE(PG8_SA(1, 1), a1 + hstep, voffA);
            PG8_WAIT_V(8); PG8_WAIT_L(0); PG8_BAR; PG8_MMA(0, 0, At, B0); PG8_MMA(0, 1, At, B1); PG8_BAR; PG8_SCHED;
            PG8_LDA(At, 0, 1); PG8_STAGE(PG8_SB(0, 0), b2, voffB); PG8_STAGE(PG8_SB(0, 1), b2 + hstep, voffB); PG8_STAGE(PG8_SA(0, 0), a2, voffA);
            PG8_WAIT_V(8); PG8_WAIT_L(0); PG8_BAR; PG8_MMA(1, 0, At, B0); PG8_MMA(1, 1, At, B1); PG8_BAR; PG8_SCHED;
            PG8_LDB(B0, 1, 0); PG8_LDB(B1, 1, 1); PG8_SCHED; PG8_LDA(At, 1, 0); PG8_STAGE(PG8_SA(0, 1), a2 + hstep, voffA);
            PG8_WAIT_V(8); PG8_WAIT_L(0); PG8_BAR; PG8_MMA(0, 0, At, B0); PG8_MMA(0, 1, At, B1); PG8_BAR; PG8_SCHED;
            PG8_LDA(At, 1, 1); PG8_STAGE(PG8_SB(1, 0), b3, voffB); PG8_STAGE(PG8_SB(1, 1), b3 + hstep, voffB); PG8_STAGE(PG8_SA(1, 0), a3, voffA);
            PG8_WAIT_V(8); PG8_WAIT_L(0); PG8_BAR; PG8_MMA(1, 0, At, B0); PG8_MMA(1, 1, At, B1); PG8_BAR; PG8_SCHED;
            } else {
            PG8_LDB(B0, 0, 0); PG8_SCHED; PG8_LDA(At, 0, 0); PG8_STAGE(PG8_SA(1, 1), a1 + hstep, voffA);
            PG8_WAIT_L(8); PG8_BAR; PG8_WAIT_L(0); PG8_MMA(0, 0, At, B0); PG8_BAR; PG8_SCHED;
            PG8_LDB(B1, 0, 1); PG8_STAGE(PG8_SB(0, 0), b2, voffB);
            PG8_BAR; PG8_WAIT_L(0); PG8_MMA(0, 1, At, B1); PG8_BAR;
            PG8_LDA(At, 0, 1); PG8_STAGE(PG8_SA(0, 0), a2, voffA);
            PG8_BAR; PG8_WAIT_L(0); PG8_MMA(1, 0, At, B0); PG8_BAR; PG8_SCHED;
            PG8_STAGE(PG8_SB(0, 1), b2 + hstep, voffB);
            PG8_WAIT_V(6); PG8_BAR; PG8_MMA(1, 1, At, B1); PG8_BAR;
            PG8_LDB(B0, 1, 0); PG8_SCHED; PG8_LDA(At, 1, 0); PG8_STAGE(PG8_SA(0, 1), a2 + hstep, voffA);
            PG8_WAIT_L(8); PG8_BAR; PG8_WAIT_L(0); PG8_MMA(0, 0, At, B0); PG8_BAR; PG8_SCHED;
            PG8_LDB(B1, 1, 1); PG8_STAGE(PG8_SB(1, 0), b3, voffB);
            PG8_BAR; PG8_WAIT_L(0); PG8_MMA(0, 1, At, B1); PG8_BAR;
            PG8_LDA(At, 1, 1); PG8_STAGE(PG8_SA(1, 0), a3, voffA);
            PG8_BAR; PG8_WAIT_L(0); PG8_MMA(1, 0, At, B0); PG8_BAR; PG8_SCHED;
            PG8_STAGE(PG8_SB(1, 1), b3 + hstep, voffB);
            PG8_WAIT_V(6); PG8_BAR; PG8_MMA(1, 1, At, B1); PG8_BAR;
            }
        }
        if constexpr (ALIGN_EPI) { if (wr == 0) PG8_BAR; }
        if constexpr (!Epi::AFTER_DRAIN) { E(acc, cur, wr, wc, fr, fq); S.done(cur); }
        if (!has_next) break;
#pragma unroll
        for (int a = 0; a < 2; ++a)
#pragma unroll
            for (int b = 0; b < 2; ++b)
#pragma unroll
                for (int m = 0; m < 4; ++m)
#pragma unroll
                    for (int n = 0; n < 2; ++n) acc[a][b][m][n] = (f32x4){0.f, 0.f, 0.f, 0.f};
        cur = nxt; cA = nA; cB = nB; ++ui;
        if constexpr (ALIGN_EPI) { if (wr == 1) PG8_BAR; }
    }
    PG8_WAIT_V(0);
    if constexpr (!ALIGN_EPI) { if (wr == 0) PG8_BAR; }
    PG8_BAR;
    if constexpr (Epi::AFTER_DRAIN) { E.fused(acc, cur, wr, wc, fr, fq, lds, wid, lane); S.done(cur); }
#undef PG8_SA
#undef PG8_SB
#undef PG8_STAGE
#undef PG8_LDA
#undef PG8_LDB
#undef PG8_MMA
#undef PG8_WAIT_V
#undef PG8_WAIT_L
#undef PG8_BAR
#undef PG8_SCHED
}
}

#define LAS __attribute__((address_space(3)))
typedef unsigned short bf16_t;
typedef float f32x4 __attribute__((ext_vector_type(4)));
typedef unsigned u32x4 __attribute__((ext_vector_type(4)));
typedef unsigned u32x2 __attribute__((ext_vector_type(2)));
constexpr int SEQ = 8192, DM = 2048, DEPTH = 2, DFF = 8192;
constexpr int PROJ_W = 5136, PROJ_P = 5376;
constexpr int C_AQ = 0, C_AK = 768, C_AV = 1024, C_BQ = 1280, C_BK = 1664, C_BV = 2048, C_BR = 2816, C_CQ = 3584, C_CK = 4096, C_CV = 4608, C_LR = 5120;
constexpr float RMS_EPS = 1e-6f;
constexpr int NWAVES = 8, NTHREADS = 512;
constexpr int LDS_BYTES = 147456;

constexpr size_t MiB = 1u << 20;
constexpr size_t WS_CTL = 0;
constexpr size_t WS_ROWSS = 1 * MiB;
constexpr size_t WS_DECAY = 3 * MiB;
constexpr size_t WS_WT = 4 * MiB;
constexpr size_t WT_IN = 0, WT_OUT = 21 * MiB, WT_1 = 29 * MiB, WT_2 = 61 * MiB, WT_LAYER = 93 * MiB;
constexpr size_t WS_XB = 190 * MiB;
constexpr size_t WS_PROJ = 222 * MiB;
constexpr size_t WS_OA = 306 * MiB;
constexpr size_t WS_OC = 330 * MiB;
constexpr size_t WS_OB = 346 * MiB;
constexpr size_t WS_DSTATE = 370 * MiB;
constexpr size_t WS_SPREV = 406 * MiB;
constexpr size_t WS_QDEC = 424 * MiB;
constexpr size_t WS_MIXED = 430 * MiB;
constexpr size_t WS_HID = 222 * MiB;
constexpr size_t WS_END = 462 * MiB;

__device__ const unsigned char T5B[128] = {0, 1, 2, 3, 4, 5, 6, 7, 8, 9, 10, 11, 12, 13, 14, 15, 16, 16, 16, 17, 17, 18, 18, 18, 19, 19, 19, 20, 20, 20, 20, 21, 21, 21, 21, 22, 22, 22, 22, 22, 23, 23, 23, 23, 23, 23, 24, 24, 24, 24, 24, 24, 25, 25, 25, 25, 25, 25, 25, 26, 26, 26, 26, 26, 26, 26, 26, 27, 27, 27, 27, 27, 27, 27, 27, 27, 27, 28, 28, 28, 28, 28, 28, 28, 28, 28, 28, 29, 29, 29, 29, 29, 29, 29, 29, 29, 29, 29, 29, 30, 30, 30, 30, 30, 30, 30, 30, 30, 30, 30, 30, 30, 30, 31, 31, 31, 31, 31, 31, 31, 31, 31, 31, 31, 31, 31, 31, 31};

__device__ __forceinline__ float bf2f(bf16_t u) { return __uint_as_float((unsigned)u << 16); }
__device__ __forceinline__ float bflo(unsigned x) { return __uint_as_float(x << 16); }
__device__ __forceinline__ float bfhi(unsigned x) { return __uint_as_float(x & 0xffff0000u); }
__device__ __forceinline__ unsigned f2bf(float f) { unsigned u = __float_as_uint(f); return (u + 0x7fffu + ((u >> 16) & 1u)) >> 16; }
__device__ __forceinline__ unsigned pk2(float lo, float hi) { return f2bf(lo) | (f2bf(hi) << 16); }
__device__ __forceinline__ float wave_sum(float v) {
#pragma unroll
    for (int o = 1; o < 64; o <<= 1) v += __shfl_xor(v, o);
    return v;
}
__device__ __forceinline__ float wave_max(float v) {
#pragma unroll
    for (int o = 1; o < 64; o <<= 1) v = fmaxf(v, __shfl_xor(v, o));
    return v;
}
__device__ __forceinline__ float wave_incl_scan(float x, int lane) {
#pragma unroll
    for (int o = 1; o < 64; o <<= 1) { const float y = __shfl_up(x, o); if (lane >= o) x += y; }
    return x;
}
__device__ __forceinline__ float softplusf(float z) { return fmaxf(z, 0.f) + log1pf(__expf(-fabsf(z))); }
#define LDS_WAIT() asm volatile("s_waitcnt lgkmcnt(0)" ::: "memory")

namespace pg8 {
template <int ACT> struct EpiScale {
    static constexpr bool PERM = true, AFTER_DRAIN = false;
    bf16_t* O; int ldc; const float* rowss;
    __device__ __forceinline__ void operator()(const f32x4 (&acc)[2][2][4][2], const Unit& u, int wr, int wc, int fr, int fq) const {
        const int row0 = u.pm * BM + wr * 64 + fr, col0 = u.pn * BM + wc * 32 + 8 * fq;
#pragma unroll
        for (int ai = 0; ai < 2; ++ai)
#pragma unroll
            for (int m = 0; m < 4; ++m) {
                const int row = row0 + ai * HALF + m * 16;
                const f32x4* pp = (const f32x4*)(rowss + (size_t)row * 32 + fq * 8);
                const f32x4 pa = pp[0], pb = pp[1];
                float s = ((pa[0] + pa[1]) + (pa[2] + pa[3])) + ((pb[0] + pb[1]) + (pb[2] + pb[3]));
                s += __shfl_xor(s, 16); s += __shfl_xor(s, 32);
                const float rstd = rsqrtf(s * (1.0f / 2048.0f) + 1e-6f);
                bf16_t* rowp = O + (size_t)row * ldc + col0;
#pragma unroll
                for (int bj = 0; bj < 2; ++bj) {
                    f32x4 v0 = acc[ai][bj][m][0] * rstd, v1 = acc[ai][bj][m][1] * rstd;
                    if (ACT == 1) {
#pragma unroll
                        for (int e = 0; e < 4; ++e) { const float a = fmaxf(v0[e], 0.f), b = fmaxf(v1[e], 0.f); v0[e] = a * a; v1[e] = b * b; }
                    }
                    u32x4 w; w.x = cvt_pk_bf16(v0[0], v0[1]); w.y = cvt_pk_bf16(v0[2], v0[3]); w.z = cvt_pk_bf16(v1[0], v1[1]); w.w = cvt_pk_bf16(v1[2], v1[3]);
                    *(u32x4*)(rowp + bj * HALF) = w;
                }
            }
    }
};
struct EpiResid {
    static constexpr bool PERM = true, AFTER_DRAIN = false;
    const float* base; float* out; bf16_t* xb; float* rowss;
    __device__ __forceinline__ void operator()(const f32x4 (&acc)[2][2][4][2], const Unit& u, int wr, int wc, int fr, int fq) const {
        const int row0 = u.pm * BM + wr * 64 + fr, col0 = u.pn * BM + wc * 32 + 8 * fq;
#pragma unroll
        for (int ai = 0; ai < 2; ++ai)
#pragma unroll
            for (int m = 0; m < 4; ++m) {
                const int row = row0 + ai * HALF + m * 16;
                const size_t off = (size_t)row * 2048 + col0;
                float ss = 0.f;
#pragma unroll
                for (int bj = 0; bj < 2; ++bj) {
                    f32x4 o0 = *(const f32x4*)(base + off + bj * HALF), o1 = *(const f32x4*)(base + off + bj * HALF + 4);
                    o0 += acc[ai][bj][m][0]; o1 += acc[ai][bj][m][1];
                    *(f32x4*)(out + off + bj * HALF) = o0; *(f32x4*)(out + off + bj * HALF + 4) = o1;
                    ss += ((o0[0] * o0[0] + o0[1] * o0[1]) + (o0[2] * o0[2] + o0[3] * o0[3])) + ((o1[0] * o1[0] + o1[1] * o1[1]) + (o1[2] * o1[2] + o1[3] * o1[3]));
                    u32x4 w; w.x = cvt_pk_bf16(o0[0], o0[1]); w.y = cvt_pk_bf16(o0[2], o0[3]); w.z = cvt_pk_bf16(o1[0], o1[1]); w.w = cvt_pk_bf16(o1[2], o1[3]);
                    *(u32x4*)(xb + off + bj * HALF) = w;
                }
                ss += __shfl_xor(ss, 16); ss += __shfl_xor(ss, 32);
                if (fq == 0) rowss[(size_t)row * 32 + u.pn * 4 + wc] = ss;
                if (m & 1) asm volatile("" ::: "memory");
            }
    }
};
}

__device__ __forceinline__ void p0_transpose_item(const float* __restrict__ W, int K, int N, const float* __restrict__ gain, bf16_t* __restrict__ WT, int kind, LAS float* scr, int item, int lane) {
    const int nblk = (kind == 1) ? (PROJ_P / 64) : (N / 64);
    const int kb = item / nblk, nb = item % nblk, k0 = 64 * kb, n0 = 64 * nb;
    int src0 = n0, nvalid = 64;
    if (kind == 1) { if (n0 < 3584) { src0 = n0; } else if (n0 < 5120) { src0 = n0 + 16; } else if (n0 == 5120) { src0 = 3584; nvalid = 16; } else { src0 = 0; nvalid = 0; } }
    const int c4 = (lane & 15) * 4;
#pragma unroll 4
    for (int i = 0; i < 16; ++i) {
        const int kk = 4 * i + (lane >> 4);
        f32x4 v = (f32x4){0.f, 0.f, 0.f, 0.f};
        if (c4 < nvalid) v = *(const f32x4*)(W + (size_t)(k0 + kk) * N + src0 + c4);
        const float g = gain ? gain[k0 + kk] : 1.0f;
        LAS float* d = scr + kk * 65 + c4;
        d[0] = v[0] * g; d[1] = v[1] * g; d[2] = v[2] * g; d[3] = v[3] * g;
    }
    LDS_WAIT();
    const int c = lane & 7;
#pragma unroll
    for (int j = 0; j < 8; ++j) {
        const int n = 8 * j + (lane >> 3);
        const LAS float* s = scr + (8 * c) * 65 + n;
        u32x4 o; o.x = pk2(s[0 * 65], s[1 * 65]); o.y = pk2(s[2 * 65], s[3 * 65]); o.z = pk2(s[4 * 65], s[5 * 65]); o.w = pk2(s[6 * 65], s[7 * 65]);
        *(u32x4*)(WT + (size_t)(n0 + n) * K + k0 + 8 * c) = o;
    }
    LDS_WAIT();
}

__device__ __forceinline__ void swa_naive_item(const bf16_t* __restrict__ proj, const float* __restrict__ sinks, const float* __restrict__ relb, float* __restrict__ Oa, int t, int hq, LAS float* qs, int lane) {
    const int hk = hq / 3;
    LDS_WAIT();
    qs[lane] = bf2f(proj[(size_t)t * PROJ_P + C_AQ + hq * 64 + lane]);
    LDS_WAIT();
    float logit[2];
#pragma unroll
    for (int e = 0; e < 2; ++e) {
        const int dist = lane + 64 * e, s = t - dist;
        float acc = 0.f;
        if (s >= 0) {
            const u32x4* kr = (const u32x4*)(proj + (size_t)s * PROJ_P + C_AK + hk * 64);
#pragma unroll
            for (int c = 0; c < 8; ++c) {
                const u32x4 kv = kr[c];
                const f32x4 a = *(const LAS f32x4*)(qs + 8 * c), b = *(const LAS f32x4*)(qs + 8 * c + 4);
                acc += bflo(kv.x) * a[0] + bfhi(kv.x) * a[1] + bflo(kv.y) * a[2] + bfhi(kv.y) * a[3] + bflo(kv.z) * b[0] + bfhi(kv.z) * b[1] + bflo(kv.w) * b[2] + bfhi(kv.w) * b[3];
            }
            logit[e] = acc * 0.125f + relb[(int)T5B[dist] * 12 + hq];
        } else logit[e] = -1e30f;
    }
    const float sink = sinks[hq];
    float m = wave_max(fmaxf(logit[0], logit[1])); m = fmaxf(m, sink);
    const float e0 = (t - lane >= 0) ? __expf(logit[0] - m) : 0.f, e1 = (t - lane - 64 >= 0) ? __expf(logit[1] - m) : 0.f;
    const float den = wave_sum(e0 + e1) + __expf(sink - m);
    const float p0 = e0 / den, p1 = e1 / den;
    float o = 0.f;
    const bf16_t* vcol = proj + C_AV + hk * 64 + lane;
    for (int i = 0; i < 64; ++i) { const float pi = __shfl(p0, i); const int s = t - i; if (s >= 0) o += pi * bf2f(vcol[(size_t)s * PROJ_P]); }
    for (int i = 0; i < 64; ++i) { const float pi = __shfl(p1, i); const int s = t - 64 - i; if (s >= 0) o += pi * bf2f(vcol[(size_t)s * PROJ_P]); }
    Oa[(size_t)t * 768 + hq * 64 + lane] = o;
}
__device__ __forceinline__ void sb_naive_item(const bf16_t* __restrict__ proj, float* __restrict__ Oc, int t, int h, LAS float* qs, int lane) {
    LDS_WAIT();
    qs[lane] = bf2f(proj[(size_t)t * PROJ_P + C_CQ + h * 64 + lane]);
    LDS_WAIT();
    float R = 0.f, o = 0.f;
    const bf16_t* vcol = proj + C_CV + h * 64 + lane;
    for (int s_hi = t - 1; s_hi >= 0; s_hi -= 64) {
        const int s = s_hi - lane;
        float z = 0.f, L = 0.f;
        if (s >= 0) {
            const u32x4* kr = (const u32x4*)(proj + (size_t)s * PROJ_P + C_CK + h * 64);
            float acc = 0.f;
#pragma unroll
            for (int c = 0; c < 8; ++c) {
                const u32x4 kv = kr[c];
                const f32x4 a = *(const LAS f32x4*)(qs + 8 * c), b = *(const LAS f32x4*)(qs + 8 * c + 4);
                acc += bflo(kv.x) * a[0] + bfhi(kv.x) * a[1] + bflo(kv.y) * a[2] + bfhi(kv.y) * a[3] + bflo(kv.z) * b[0] + bfhi(kv.z) * b[1] + bflo(kv.w) * b[2] + bfhi(kv.w) * b[3];
            }
            z = acc * 0.125f; L = -softplusf(z);
        }
        const float C = R + wave_incl_scan(L, lane);
        const float w = (s >= 0) ? __expf(z + C) : 0.f;
        R = __shfl(C, 63);
        const int nk = (s_hi + 1 < 64) ? (s_hi + 1) : 64;
        for (int i = 0; i < nk; ++i) { const float wi = __shfl(w, i); o += wi * bf2f(vcol[(size_t)(s_hi - i) * PROJ_P]); }
        if (R < -105.0f) break;
    }
    Oc[(size_t)t * 512 + h * 64 + lane] = o;
}
__device__ __forceinline__ void gla_seq_item(const bf16_t* __restrict__ proj, const float* __restrict__ lgate, float* __restrict__ Ob, int h, int j, int lane) {
    float s0 = 0.f, s1 = 0.f;
    const bool two = lane < 32;
    const int kA = h * 96 + lane, kB = h * 96 + 64 + (lane & 31);
    for (int t0 = 0; t0 < SEQ; t0 += 8) {
        float g0[8], k0[8], q0[8], g1[8], k1[8], q1[8], vv[8];
#pragma unroll
        for (int u = 0; u < 8; ++u) {
            const bf16_t* row = proj + (size_t)(t0 + u) * PROJ_P; const float* lg = lgate + (size_t)(t0 + u) * 384;
            g0[u] = lg[kA]; k0[u] = bf2f(row[C_BK + kA]); q0[u] = bf2f(row[C_BQ + kA]);
            g1[u] = lg[kB]; k1[u] = bf2f(row[C_BK + kB]); q1[u] = bf2f(row[C_BQ + kB]);
            vv[u] = bf2f(row[C_BV + h * 192 + j]);
        }
#pragma unroll
        for (int u = 0; u < 8; ++u) {
            s0 = __expf(g0[u]) * s0 + k0[u] * vv[u];
            s1 = __expf(g1[u]) * s1 + k1[u] * vv[u];
            float a = q0[u] * s0 + (two ? q1[u] * s1 : 0.f);
            a = wave_sum(a);
            if (lane == 0) Ob[(size_t)(t0 + u) * 768 + h * 192 + j] = a * 0.10206207261596577f;
        }
    }
}
__device__ __forceinline__ void norm_mixed_row(const float* __restrict__ Oa, const float* __restrict__ Ob, const float* __restrict__ Oc, const bf16_t* __restrict__ proj,
                                               const float* __restrict__ gA, const float* __restrict__ gB, const float* __restrict__ gC, bf16_t* __restrict__ mixed, int t, int lane) {
    bf16_t* mrow = mixed + (size_t)t * 2048;
    {
        float a[12], ss = 0.f;
#pragma unroll
        for (int i = 0; i < 12; ++i) { a[i] = Oa[(size_t)t * 768 + lane + 64 * i]; ss += a[i] * a[i]; }
        const float r = rsqrtf(wave_sum(ss) * (1.0f / 768.0f) + RMS_EPS);
#pragma unroll
        for (int i = 0; i < 12; ++i) mrow[lane + 64 * i] = (bf16_t)f2bf(a[i] * r * gA[lane + 64 * i]);
    }
#pragma unroll
    for (int h = 0; h < 4; ++h) {
        float b[3], ss = 0.f;
#pragma unroll
        for (int i = 0; i < 3; ++i) { b[i] = Ob[(size_t)t * 768 + h * 192 + lane + 64 * i]; ss += b[i] * b[i]; }
        const float r = rsqrtf(wave_sum(ss) * (1.0f / 192.0f) + RMS_EPS);
#pragma unroll
        for (int i = 0; i < 3; ++i) {
            const int c = lane + 64 * i;
            const float br = bf2f(proj[(size_t)t * PROJ_P + C_BR + h * 192 + c]);
            const float y = b[i] * r * gB[c] * (br / (1.0f + __expf(-br)));
            mrow[768 + h * 192 + c] = (bf16_t)f2bf(y);
        }
    }
    {
        float a[8], ss = 0.f;
#pragma unroll
        for (int i = 0; i < 8; ++i) { a[i] = Oc[(size_t)t * 512 + lane + 64 * i]; ss += a[i] * a[i]; }
        const float r = rsqrtf(wave_sum(ss) * (1.0f / 512.0f) + RMS_EPS);
#pragma unroll
        for (int i = 0; i < 8; ++i) mrow[1536 + lane + 64 * i] = (bf16_t)f2bf(a[i] * r * gC[lane + 64 * i]);
    }
}

#ifndef PH_MASK
#define PH_MASK 0x1ff
#endif
#define HAS(k) (((PH_MASK) >> (k)) & 1)
struct Params { const float* in[15]; float* out; unsigned char* ws; int ph_lo, ph_hi; };
constexpr int N_PHASES = 16;

__global__ void __launch_bounds__(NTHREADS, 2) mega(Params p) {
    extern __shared__ __attribute__((aligned(16))) unsigned char lds_raw[];
    LAS unsigned char* lds = (LAS unsigned char*)lds_raw;
    cg::grid_group grid = cg::this_grid();
    const int G = gridDim.x;
    unsigned char* ws = p.ws;
    const float* x_in = p.in[0];
    float* xres = p.out;
    bf16_t* xb = (bf16_t*)(ws + WS_XB);
    float* rowss = (float*)(ws + WS_ROWSS);
    bf16_t* proj = (bf16_t*)(ws + WS_PROJ);
    float* Oa = (float*)(ws + WS_OA); float* Ob = (float*)(ws + WS_OB); float* Oc = (float*)(ws + WS_OC);
    float* lgate = (float*)(ws + WS_DSTATE);
    bf16_t* mixed = (bf16_t*)(ws + WS_MIXED);
    bf16_t* hid = (bf16_t*)(ws + WS_HID);
#define IN(k) (p.ph_lo <= (k) && (k) < p.ph_hi)
#define SYNC(k) do { if (IN(k) && IN((k) + 1)) grid.sync(); } while (0)
#define PHASE_IDS() int tid = threadIdx.x; asm volatile("" : "+v"(tid)); const int lane = tid & 63, wave = __builtin_amdgcn_readfirstlane(tid >> 6), gw = blockIdx.x * NWAVES + wave, NGW = G * NWAVES; (void)lane; (void)gw; (void)NGW

    if (HAS(0) && IN(0)) {
        PHASE_IDS();
        LAS float* scr = (LAS float*)(lds + wave * 16640);
        constexpr int I_IN = 32 * (PROJ_P / 64), I_OUT = 32 * 32, I_1 = 32 * 128, I_2 = 128 * 32, I_L = I_IN + I_OUT + I_1 + I_2;
        for (int it = gw; it < DEPTH * I_L; it += NGW) {
            const int l = it / I_L; int r = it % I_L;
            unsigned char* wt = ws + WS_WT + (size_t)l * WT_LAYER;
            if (r < I_IN) { p0_transpose_item(p.in[2] + (size_t)l * DM * PROJ_W, DM, PROJ_W, p.in[1] + l * DM, (bf16_t*)(wt + WT_IN), 1, scr, r, lane); continue; } r -= I_IN;
            if (r < I_OUT) { p0_transpose_item(p.in[10] + (size_t)l * DM * DM, DM, DM, nullptr, (bf16_t*)(wt + WT_OUT), 0, scr, r, lane); continue; } r -= I_OUT;
            if (r < I_1) { p0_transpose_item(p.in[12] + (size_t)l * DM * DFF, DM, DFF, p.in[11] + l * DM, (bf16_t*)(wt + WT_1), 0, scr, r, lane); continue; } r -= I_1;
            p0_transpose_item(p.in[13] + (size_t)l * DFF * DM, DFF, DM, nullptr, (bf16_t*)(wt + WT_2), 0, scr, r, lane);
        }
        for (int m = gw; m < SEQ; m += NGW) {
            const f32x4* xr = (const f32x4*)(x_in + (size_t)m * DM) + lane;
            f32x4 v[8]; float ss = 0.f;
#pragma unroll
            for (int j = 0; j < 8; ++j) { v[j] = xr[64 * j]; ss += (v[j][0] * v[j][0] + v[j][1] * v[j][1]) + (v[j][2] * v[j][2] + v[j][3] * v[j][3]); }
            ss = wave_sum(ss);
            u32x2* o8 = (u32x2*)(xb + (size_t)m * DM) + lane;
#pragma unroll
            for (int j = 0; j < 8; ++j) { u32x2 w; w.x = pk2(v[j][0], v[j][1]); w.y = pk2(v[j][2], v[j][3]); o8[64 * j] = w; }
            if (lane < 32) rowss[(size_t)m * 32 + lane] = (lane == 0) ? ss : 0.f;
        }
    }
    SYNC(0);
    for (int l = 0; l < DEPTH; ++l) {
        const int pb = 1 + 7 * l;
        unsigned char* wt = ws + WS_WT + (size_t)l * WT_LAYER;
        if (HAS(1) && IN(pb + 0)) {
            pg8::Gemm g{xb, (const bf16_t*)(wt + WT_IN), SEQ, PROJ_P, DM}; pg8::StaticOrder S; S.init(SEQ, PROJ_P, G, (int)blockIdx.x);
            pg8::EpiScale<0> E{proj, PROJ_P, rowss};
            pg8::gemm_phase<pg8::EpiScale<0>, pg8::StaticOrder, true, true>(lds, g, S, E);
        }
        SYNC(pb + 0);
        if (HAS(2) && IN(pb + 1)) {
            PHASE_IDS();
            const float* gwt = p.in[5] + (size_t)l * 16 * 384; const float* gbs = p.in[6] + l * 384;
            for (int idx = blockIdx.x * NTHREADS + tid; idx < SEQ * 384; idx += G * NTHREADS) {
                const int t = idx / 384, c = idx % 384;
                const bf16_t* lr = proj + (size_t)t * PROJ_P + C_LR;
                float gp = gbs[c];
#pragma unroll
                for (int r = 0; r < 16; ++r) gp += bf2f(lr[r]) * gwt[r * 384 + c];
                const float ls = fminf(gp, 0.f) - log1pf(__expf(-fabsf(gp)));
                lgate[idx] = fmaxf(ls * (1.0f / 16.0f), -1.0f);
            }
            LAS float* qs = (LAS float*)lds + wave * 64;
            const float* sinks = p.in[3] + l * 12; const float* relb = p.in[4];
            for (int it = gw; it < SEQ * 12; it += NGW) swa_naive_item(proj, sinks, relb, Oa, it / 12, it % 12, qs, lane);
            for (int it = gw; it < SEQ * 8; it += NGW) sb_naive_item(proj, Oc, it / 8, it % 8, qs, lane);
        }
        SYNC(pb + 1);
        if (HAS(3) && IN(pb + 2)) {
            PHASE_IDS();
            for (int it = gw; it < 4 * 192; it += NGW) gla_seq_item(proj, lgate, Ob, it / 192, it % 192, lane);
        }
        SYNC(pb + 2);
        if (HAS(4) && IN(pb + 3)) {
            PHASE_IDS();
            const float* gA = p.in[8] + l * 768; const float* gB = p.in[7] + l * 192; const float* gC = p.in[9] + l * 512;
            for (int t = gw; t < SEQ; t += NGW) norm_mixed_row(Oa, Ob, Oc, proj, gA, gB, gC, mixed, t, lane);
        }
        SYNC(pb + 3);
        if (HAS(5) && IN(pb + 4)) {
            pg8::Gemm g{mixed, (const bf16_t*)(wt + WT_OUT), SEQ, DM, DM}; pg8::StaticOrder S; S.init(SEQ, DM, G, (int)blockIdx.x);
            pg8::EpiResid E{l == 0 ? x_in : xres, xres, xb, rowss};
            pg8::gemm_phase<pg8::EpiResid, pg8::StaticOrder, true, true>(lds, g, S, E);
        }
        SYNC(pb + 4);
        if (HAS(6) && IN(pb + 5)) {
            pg8::Gemm g{xb, (const bf16_t*)(wt + WT_1), SEQ, DFF, DM}; pg8::StaticOrder S; S.init(SEQ, DFF, G, (int)blockIdx.x);
            pg8::EpiScale<1> E{hid, DFF, rowss};
            pg8::gemm_phase<pg8::EpiScale<1>, pg8::StaticOrder, true, true>(lds, g, S, E);
        }
        SYNC(pb + 5);
        if (HAS(7) && IN(pb + 6)) {
            pg8::Gemm g{hid, (const bf16_t*)(wt + WT_2), SEQ, DM, DFF}; pg8::StaticOrder S; S.init(SEQ, DM, G, (int)blockIdx.x);
            pg8::EpiResid E{xres, xres, xb, rowss};
            pg8::gemm_phase<pg8::EpiResid, pg8::StaticOrder, true, true>(lds, g, S, E);
        }
        SYNC(pb + 6);
    }
    if (HAS(8) && IN(N_PHASES - 1)) {
        PHASE_IDS();
        const float* gF = p.in[14];
        for (int m = gw; m < SEQ; m += NGW) {
            const float part = (lane < 32) ? rowss[(size_t)m * 32 + lane] : 0.f;
            const float rstd = rsqrtf(wave_sum(part) * (1.0f / 2048.0f) + RMS_EPS);
            f32x4* xr = (f32x4*)(xres + (size_t)m * DM) + lane;
            const f32x4* gr = (const f32x4*)gF + lane;
#pragma unroll
            for (int j = 0; j < 8; ++j) { f32x4 v = xr[64 * j]; const f32x4 g = gr[64 * j]; v = v * rstd * g; xr[64 * j] = v; }
        }
    }
}

#ifndef MK_N_LAUNCHES
#define MK_N_LAUNCHES 1
#endif
extern "C" void kernel_launch(void* const* d_in, const int* in_sizes, int n_in, void* d_out, int out_size, void* d_ws, size_t ws_size, hipStream_t stream) {
    static int grid = 0;
    if (grid == 0) {
        if (n_in != 15 || out_size != SEQ * DM || ws_size < WS_END) { fprintf(stderr, "kernel_launch: unexpected shapes (n_in %d out %d ws %zu)\n", n_in, out_size, ws_size); grid = -1; return; }
        int dev = 0, cus = 0, per_cu = 0;
        hipGetDevice(&dev);
        hipDeviceGetAttribute(&cus, hipDeviceAttributeMultiprocessorCount, dev);
        hipFuncSetAttribute((const void*)mega, hipFuncAttributeMaxDynamicSharedMemorySize, LDS_BYTES);
        hipOccupancyMaxActiveBlocksPerMultiprocessor(&per_cu, (const void*)mega, NTHREADS, LDS_BYTES);
        if (per_cu < 1) { fprintf(stderr, "kernel_launch: occupancy query says %d blocks/CU\n", per_cu); per_cu = 1; }
        (void)hipGetLastError();
        grid = cus * 1;
    }
    if (grid < 0) return;
    Params p{};
    for (int i = 0; i < 15; ++i) p.in[i] = (const float*)d_in[i];
    p.out = (float*)d_out; p.ws = (unsigned char*)d_ws;
    if (MK_N_LAUNCHES == 1) {
        p.ph_lo = 0; p.ph_hi = N_PHASES;
        void* args[] = {&p};
        hipError_t e = hipLaunchCooperativeKernel((const void*)mega, dim3(grid), dim3(NTHREADS), args, LDS_BYTES, stream);
        if (e != hipSuccess) fprintf(stderr, "cooperative launch failed: %s (grid %d)\n", hipGetErrorString(e), grid);
    } else {
        for (int ph = 0; ph < N_PHASES; ++ph) {
            p.ph_lo = ph; p.ph_hi = ph + 1;
            hipLaunchKernelGGL(mega, dim3(grid), dim3(NTHREADS), LDS_BYTES, stream, p);
        }
    }
}
```

```cpp
#include <hip/hip_runtime.h>
#include <hip/hip_cooperative_groups.h>
#include <cstdio>
#include <cstdint>
namespace cg = cooperative_groups;
namespace pg8 {
#define PG8_LAS __attribute__((address_space(3)))
typedef unsigned short bf16_t;
typedef short bf16x8 __attribute__((ext_vector_type(8)));
typedef float f32x4 __attribute__((ext_vector_type(4)));
typedef unsigned u32x4 __attribute__((ext_vector_type(4)));
constexpr int BM = 256, BK = 64, HALF = 128, HTB = HALF * BK * 2  , STAGE_BYTES = 8 * HTB, NXCD = 8, WGM = 8;

__host__ __device__ __forceinline__ int lds_byte(int r, int c) { const int st = (r >> 4) * 2 + (c >> 5), rr = r & 15, cc = c & 31, ob = rr * 64 + cc * 2; return st * 1024 + (ob ^ (((ob >> 9) & 1) << 5)); }
__host__ __device__ __forceinline__ void stage_rc(int b, int& R, int& C) { const int st = b / 1024, sb = b % 1024, swz = sb ^ (((sb >> 9) & 1) << 5); R = (st >> 1) * 16 + swz / 64; C = (st & 1) * 32 + (swz % 64) / 2; }
__host__ __device__ __forceinline__ int perm32(int rho) { const int n = rho >> 4, i = rho & 15; return 8 * (i >> 2) + 4 * n + (i & 3); }

struct Unit { int pm, pn; };
struct Gemm { const bf16_t* A; const bf16_t* Bt; int M, N, K; };

struct StaticOrder {
    int nM, nN, nwg, G, c;
    __host__ __device__ void init(int M, int N, int G_, int c_) { nM = M / BM; nN = N / BM; nwg = nM * nN; G = G_; c = c_; }
    __host__ __device__ bool next(int i, Unit& u) const {
        const long L = (long)i * G + c; if (L >= nwg) return false;
        int wgid = (int)L; { const int q = nwg / NXCD, r = nwg % NXCD, xcd = wgid % NXCD, off = wgid / NXCD; wgid = (xcd < r ? xcd * (q + 1) : r * (q + 1) + (xcd - r) * q) + off; }
        const int nig = WGM * nN, gid = wgid / nig, fm = gid * WGM, gsz = (nM - fm) < WGM ? (nM - fm) : WGM;
        u.pm = fm + ((wgid % nig) % gsz); u.pn = (wgid % nig) / gsz; return true;
    }
    __device__ __forceinline__ void a_ready(const Unit&) const {}
    __device__ __forceinline__ void done(const Unit&) const {}
};
__device__ __forceinline__ unsigned cvt_pk_bf16(float lo, float hi) { unsigned r; asm volatile("v_cvt_pk_bf16_f32 %0, %1, %2" : "=v"(r) : "v"(lo), "v"(hi)); return r; }
typedef float f32x2 __attribute__((ext_vector_type(2)));
template <class Epi, class Sched, bool ALIGN_EPI = false, bool SP2 = false>
__device__ __forceinline__ void gemm_phase(PG8_LAS unsigned char* lds, const Gemm g, const Sched& S, const Epi& E) {
    int tid_ = threadIdx.x; asm volatile("" : "+v"(tid_));
    const int tid = tid_, wid = __builtin_amdgcn_readfirstlane(tid >> 6), lane = tid & 63, wr = wid >> 2, wc = wid & 3, fr = lane & 15, fq = lane >> 4;
    const int K = g.K, nt = K / BK;
    unsigned voffA[2], voffB[2];
#pragma unroll
    for (int i = 0; i < 2; ++i) { int R, C; stage_rc(tid * 16 + i * 8192, R, C); const int Rb = Epi::PERM ? ((R & ~31) + perm32(R & 31)) : R;
        voffA[i] = (unsigned)(R * K + C) * 2u; voffB[i] = (unsigned)(Rb * K + C) * 2u; }
    const size_t kstep = (size_t)(BK * 2);
    const size_t hstep = (size_t)HALF * K * 2;
    const size_t tstep = 2 * hstep;
    const unsigned ldsw = (unsigned)wid * 1024u;
    const int aoff = lds_byte(wr * 64 + fr, fq * 8), boff = lds_byte(wc * 32 + fr, fq * 8);
#define PG8_SA(b, h) (((b) * 2 + (h)) * HTB)
#define PG8_SB(b, h) ((4 + (b) * 2 + (h)) * HTB)
#define PG8_STAGE(bufoff, gbase, voff) do { _Pragma("unroll") for (int _i = 0; _i < 2; ++_i) \
        __builtin_amdgcn_global_load_lds((const unsigned*)((const char*)(gbase) + (voff)[_i]), (PG8_LAS unsigned*)(lds + (bufoff) + ldsw + _i * 8192), 16, 0, 0); } while (0)
#define PG8_LDA(dst, b, h) do { _Pragma("unroll") for (int m = 0; m < 4; ++m) _Pragma("unroll") for (int k = 0; k < 2; ++k) dst[m][k] = *(const PG8_LAS bf16x8*)(lds + PG8_SA(b, h) + aoff + m * 2048 + k * 1024); } while (0)
#define PG8_LDB(dst, b, h) do { _Pragma("unroll") for (int n = 0; n < 2; ++n) _Pragma("unroll") for (int k = 0; k < 2; ++k) dst[n][k] = *(const PG8_LAS bf16x8*)(lds + PG8_SB(b, h) + boff + n * 2048 + k * 1024); } while (0)
#define PG8_MMA(ai, bj, At, Bt) do { __builtin_amdgcn_s_setprio(1); _Pragma("unroll") for (int m = 0; m < 4; ++m) _Pragma("unroll") for (int n = 0; n < 2; ++n) _Pragma("unroll") for (int k = 0; k < 2; ++k) \
        acc[ai][bj][m][n] = __builtin_amdgcn_mfma_f32_16x16x32_bf16(Bt[n][k], At[m][k], acc[ai][bj][m][n], 0, 0, 0); __builtin_amdgcn_s_setprio(0); } while (0)
#define PG8_WAIT_V(n) asm volatile("s_waitcnt vmcnt(" #n ")" ::: "memory")
#define PG8_WAIT_L(n) asm volatile("s_waitcnt lgkmcnt(" #n ")" ::: "memory")
#define PG8_BAR __builtin_amdgcn_s_barrier()
#define PG8_SCHED __builtin_amdgcn_sched_barrier(0)
    Unit cur, nxt; int ui = 0;
    if (!S.next(0, cur)) return;
    f32x4 acc[2][2][4][2];
#pragma unroll
    for (int a = 0; a < 2; ++a)
#pragma unroll
        for (int b = 0; b < 2; ++b)
#pragma unroll
            for (int m = 0; m < 4; ++m)
#pragma unroll
                for (int n = 0; n < 2; ++n) acc[a][b][m][n] = (f32x4){0.f, 0.f, 0.f, 0.f};
    bf16x8 At[4][2], B0[2][2], B1[2][2];
    const char* cA = (const char*)g.A + (size_t)cur.pm * tstep; const char* cB = (const char*)g.Bt + (size_t)cur.pn * tstep;
    S.a_ready(cur);
    if constexpr (SP2) {
        PG8_STAGE(PG8_SB(0, 0), cB, voffB); PG8_STAGE(PG8_SB(0, 1), cB + hstep, voffB); PG8_STAGE(PG8_SA(0, 0), cA, voffA); PG8_STAGE(PG8_SA(0, 1), cA + hstep, voffA);
        if (wr == 1) PG8_BAR;
        PG8_WAIT_V(2); PG8_BAR;
        PG8_STAGE(PG8_SB(1, 0), cB + kstep, voffB); PG8_STAGE(PG8_SA(1, 0), cA + kstep, voffA); PG8_STAGE(PG8_SB(1, 1), cB + hstep + kstep, voffB);
        PG8_WAIT_V(6); PG8_BAR;
    } else {
        PG8_STAGE(PG8_SB(0, 0), cB, voffB); PG8_STAGE(PG8_SA(0, 0), cA, voffA); PG8_STAGE(PG8_SB(0, 1), cB + hstep, voffB); PG8_STAGE(PG8_SA(0, 1), cA + hstep, voffA);
        if (wr == 1) PG8_BAR;
        PG8_WAIT_V(4); PG8_BAR;
        PG8_STAGE(PG8_SB(1, 0), cB + kstep, voffB); PG8_STAGE(PG8_SA(1, 0), cA + kstep, voffA); PG8_STAGE(PG8_SB(1, 1), cB + hstep + kstep, voffB);
        PG8_WAIT_V(6); PG8_BAR;
    }
    for (;;) {
        const bool has_next = S.next(ui + 1, nxt);
        const char* nA = has_next ? (const char*)g.A + (size_t)nxt.pm * tstep : cA; const char* nB = has_next ? (const char*)g.Bt + (size_t)nxt.pn * tstep : cB;
        for (int t = 0; t < nt; t += 2) {
            const bool last = (t == nt - 2);
            const char* a1 = cA + (size_t)(t + 1) * kstep;
            const char* a2 = last ? nA : cA + (size_t)(t + 2) * kstep; const char* b2 = last ? nB : cB + (size_t)(t + 2) * kstep;
            const char* a3 = a2 + kstep; const char* b3 = b2 + kstep;
            if (last && has_next) S.a_ready(nxt);
            if constexpr (SP2) {
            PG8_LDB(B0, 0, 0); PG8_LDB(B1, 0, 1); PG8_SCHED; PG8_LDA(At, 0, 0); PG8_STAGE(PG8_SA(1, 1), a1 + hstep, voffA);
            PG8_WAIT_V(8); PG8_WAIT_L(0); PG8_BAR; PG8_MMA(0, 0, At, B0); PG8_MMA(0, 1, At, B1); PG8_BAR; PG8_SCHED;
            PG8_LDA(At, 0, 1); PG8_STAGE(PG8_SB(0, 0), b2, voffB); PG8_STAGE(PG8_SB(0, 1), b2 + hstep, voffB); PG8_STAGE(PG8_SA(0, 0), a2, voffA);
            PG8_WAIT_V(8); PG8_WAIT_L(0); PG8_BAR; PG8_MMA(1, 0, At, B0); PG8_MMA(1, 1, At, B1); PG8_BAR; PG8_SCHED;
            PG8_LDB(B0, 1, 0); PG8_LDB(B1, 1, 1); PG8_SCHED; PG8_LDA(At, 1, 0); PG8_STAGE(PG8_SA(0, 1), a2 + hstep, voffA);
            PG8_WAIT_V(8); PG8_WAIT_L(0); PG8_BAR; PG8_MMA(0, 0, At, B0); PG8_MMA(0, 1, At, B1); PG8_BAR; PG8_SCHED;
            PG8_LDA(At, 1, 1); PG8_STAGE(PG8_SB(1, 0), b3, voffB); PG8_STAGE(PG8_SB(1, 1), b3 + hstep, voffB); PG8_STAGE(PG8_SA(1, 0), a3, voffA);
            PG8_WAIT_V(8); PG8_WAIT_L(0); PG8_BAR; PG8_MMA(1, 0, At, B0); PG8_MMA(1, 1, At, B1); PG8_BAR; PG8_SCHED;
            } else {
            PG8_LDB(B0, 0, 0); PG8_SCHED; PG8_LDA(At, 0, 0); PG8_STAGE(PG8_SA(1, 1), a1 + hstep, voffA);
            PG8_WAIT_L(8); PG8_BAR; PG8_WAIT_L(0); PG8_MMA(0, 0, At, B0); PG8_BAR; PG8_SCHED;
            PG8_LDB(B1, 0, 1); PG8_STAGE(PG8_SB(0, 0), b2, voffB);
            PG8_BAR; PG8_WAIT_L(0); PG8_MMA(0, 1, At, B1); PG8_BAR;
            PG8_LDA(At, 0, 1); PG8_STAGE(PG8_SA(0, 0), a2, voffA);
            PG8_BAR; PG8_WAIT_L(0); PG8_MMA(1, 0, At, B0); PG8_BAR; PG8_SCHED;
            PG8_STAGE(PG8_SB(0, 1), b2 + hstep, voffB);
            PG8_WAIT_V(6); PG8_BAR; PG8_MMA(1, 1, At, B1); PG8_BAR;
            PG8_LDB(B0, 1, 0); PG8_SCHED; PG8_LDA(At, 1, 0); PG8_STAGE(PG8_SA(0, 1), a2 + hstep, voffA);
            PG8_WAIT_L(8); PG8_BAR; PG8_WAIT_L(0); PG8_MMA(0, 0, At, B0); PG8_BAR; PG8_SCHED;
            PG8_LDB(B1, 1, 1); PG8_STAGE(PG8_SB(1, 0), b3, voffB);
            PG8_BAR; PG8_WAIT_L(0); PG8_MMA(0, 1, At, B1); PG8_BAR;
            PG8_LDA(At, 1, 1); PG8_STAGE(PG8_SA(1, 0), a3, voffA);
            PG8_BAR; PG8_WAIT_L(0); PG8_MMA(1, 0, At, B0); PG8_BAR; PG8_SCHED;
            PG8_STAGE(PG8_SB(1, 1), b3 + hstep, voffB);
            PG8_WAIT_V(6); PG8_BAR; PG8_MMA(1, 1, At, B1); PG8_BAR;
            }
        }
        if constexpr (ALIGN_EPI) { if (wr == 0) PG8_BAR; }
        if constexpr (!Epi::AFTER_DRAIN) { E(acc, cur, wr, wc, fr, fq); S.done(cur); }
        if (!has_next) break;
#pragma unroll
        for (int a = 0; a < 2; ++a)
#pragma unroll
            for (int b = 0; b < 2; ++b)
#pragma unroll
                for (int m = 0; m < 4; ++m)
#pragma unroll
                    for (int n = 0; n < 2; ++n) acc[a][b][m][n] = (f32x4){0.f, 0.f, 0.f, 0.f};
        cur = nxt; cA = nA; cB = nB; ++ui;
        if constexpr (ALIGN_EPI) { if (wr == 1) PG8_BAR; }
    }
    PG8_WAIT_V(0);
    if constexpr (!ALIGN_EPI) { if (wr == 0) PG8_BAR; }
    PG8_BAR;
    if constexpr (Epi::AFTER_DRAIN) { E.fused(acc, cur, wr, wc, fr, fq, lds, wid, lane); S.done(cur); }
#undef PG8_SA
#undef PG8_SB
#undef PG8_STAGE
#undef PG8_LDA
#undef PG8_LDB
#undef PG8_MMA
#undef PG8_WAIT_V
#undef PG8_WAIT_L
#undef PG8_BAR
#undef PG8_SCHED
}
}

#define LAS __attribute__((address_space(3)))
typedef unsigned short bf16_t;
typedef float f32x4 __attribute__((ext_vector_type(4)));
typedef unsigned u32x4 __attribute__((ext_vector_type(4)));
typedef unsigned u32x2 __attribute__((ext_vector_type(2)));
constexpr int SEQ = 8192, DM = 2048, DEPTH = 2, DFF = 8192;
constexpr int PROJ_W = 5136, PROJ_P = 5376;
constexpr int C_AQ = 0, C_AK = 768, C_AV = 1024, C_BQ = 1280, C_BK = 1664, C_BV = 2048, C_BR = 2816, C_CQ = 3584, C_CK = 4096, C_CV = 4608, C_LR = 5120;
constexpr float RMS_EPS = 1e-6f;
constexpr int NWAVES = 8, NTHREADS = 512;
constexpr int LDS_BYTES = 147456;

constexpr size_t MiB = 1u << 20;
constexpr size_t WS_CTL = 0;
constexpr size_t WS_ROWSS = 1 * MiB;
constexpr size_t WS_DECAY = 3 * MiB;
constexpr size_t WS_WT = 4 * MiB;
constexpr size_t WT_IN = 0, WT_OUT = 21 * MiB, WT_1 = 29 * MiB, WT_2 = 61 * MiB, WT_LAYER = 93 * MiB;
constexpr size_t WS_XB = 190 * MiB;
constexpr size_t WS_PROJ = 222 * MiB;
constexpr size_t WS_OA = 306 * MiB;
constexpr size_t WS_OC = 330 * MiB;
constexpr size_t WS_OB = 346 * MiB;
constexpr size_t WS_DSTATE = 370 * MiB;
constexpr size_t WS_SPREV = 406 * MiB;
constexpr size_t WS_QDEC = 424 * MiB;
constexpr size_t WS_MIXED = 430 * MiB;
constexpr size_t WS_HID = 222 * MiB;
constexpr size_t WS_END = 462 * MiB;

__device__ const unsigned char T5B[128] = {0, 1, 2, 3, 4, 5, 6, 7, 8, 9, 10, 11, 12, 13, 14, 15, 16, 16, 16, 17, 17, 18, 18, 18, 19, 19, 19, 20, 20, 20, 20, 21, 21, 21, 21, 22, 22, 22, 22, 22, 23, 23, 23, 23, 23, 23, 24, 24, 24, 24, 24, 24, 25, 25, 25, 25, 25, 25, 25, 26, 26, 26, 26, 26, 26, 26, 26, 27, 27, 27, 27, 27, 27, 27, 27, 27, 27, 28, 28, 28, 28, 28, 28, 28, 28, 28, 28, 29, 29, 29, 29, 29, 29, 29, 29, 29, 29, 29, 29, 30, 30, 30, 30, 30, 30, 30, 30, 30, 30, 30, 30, 30, 30, 31, 31, 31, 31, 31, 31, 31, 31, 31, 31, 31, 31, 31, 31, 31};

__device__ __forceinline__ float bf2f(bf16_t u) { return __uint_as_float((unsigned)u << 16); }
__device__ __forceinline__ float bflo(unsigned x) { return __uint_as_float(x << 16); }
__device__ __forceinline__ float bfhi(unsigned x) { return __uint_as_float(x & 0xffff0000u); }
__device__ __forceinline__ unsigned f2bf(float f) { unsigned u = __float_as_uint(f); return (u + 0x7fffu + ((u >> 16) & 1u)) >> 16; }
__device__ __forceinline__ unsigned pk2(float lo, float hi) { return f2bf(lo) | (f2bf(hi) << 16); }
__device__ __forceinline__ float wave_sum(float v) {
#pragma unroll
    for (int o = 1; o < 64; o <<= 1) v += __shfl_xor(v, o);
    return v;
}
__device__ __forceinline__ float wave_max(float v) {
#pragma unroll
    for (int o = 1; o < 64; o <<= 1) v = fmaxf(v, __shfl_xor(v, o));
    return v;
}
__device__ __forceinline__ float wave_incl_scan(float x, int lane) {
#pragma unroll
    for (int o = 1; o < 64; o <<= 1) { const float y = __shfl_up(x, o); if (lane >= o) x += y; }
    return x;
}
__device__ __forceinline__ float softplusf(float z) { return fmaxf(z, 0.f) + log1pf(__expf(-fabsf(z))); }
#define LDS_WAIT() asm volatile("s_waitcnt lgkmcnt(0)" ::: "memory")

namespace pg8 {
template <int ACT> struct EpiScale {
    static constexpr bool PERM = true, AFTER_DRAIN = false;
    bf16_t* O; int ldc; const float* rowss;
    __device__ __forceinline__ void operator()(const f32x4 (&acc)[2][2][4][2], const Unit& u, int wr, int wc, int fr, int fq) const {
        const int row0 = u.pm * BM + wr * 64 + fr, col0 = u.pn * BM + wc * 32 + 8 * fq;
#pragma unroll
        for (int ai = 0; ai < 2; ++ai)
#pragma unroll
            for (int m = 0; m < 4; ++m) {
                const int row = row0 + ai * HALF + m * 16;
                const f32x4* pp = (const f32x4*)(rowss + (size_t)row * 32 + fq * 8);
                const f32x4 pa = pp[0], pb = pp[1];
                float s = ((pa[0] + pa[1]) + (pa[2] + pa[3])) + ((pb[0] + pb[1]) + (pb[2] + pb[3]));
                s += __shfl_xor(s, 16); s += __shfl_xor(s, 32);
                const float rstd = rsqrtf(s * (1.0f / 2048.0f) + 1e-6f);
                bf16_t* rowp = O + (size_t)row * ldc + col0;
#pragma unroll
                for (int bj = 0; bj < 2; ++bj) {
                    f32x4 v0 = acc[ai][bj][m][0] * rstd, v1 = acc[ai][bj][m][1] * rstd;
                    if (ACT == 1) {
#pragma unroll
                        for (int e = 0; e < 4; ++e) { const float a = fmaxf(v0[e], 0.f), b = fmaxf(v1[e], 0.f); v0[e] = a * a; v1[e] = b * b; }
                    }
                    u32x4 w; w.x = cvt_pk_bf16(v0[0], v0[1]); w.y = cvt_pk_bf16(v0[2], v0[3]); w.z = cvt_pk_bf16(v1[0], v1[1]); w.w = cvt_pk_bf16(v1[2], v1[3]);
                    *(u32x4*)(rowp + bj * HALF) = w;
                }
            }
    }
};
struct EpiResid {
    static constexpr bool PERM = true, AFTER_DRAIN = false;
    const float* base; float* out; bf16_t* xb; float* rowss;
    __device__ __forceinline__ void operator()(const f32x4 (&acc)[2][2][4][2], const Unit& u, int wr, int wc, int fr, int fq) const {
        const int row0 = u.pm * BM + wr * 64 + fr, col0 = u.pn * BM + wc * 32 + 8 * fq;
#pragma unroll
        for (int ai = 0; ai < 2; ++ai)
#pragma unroll
            for (int m = 0; m < 4; ++m) {
                const int row = row0 + ai * HALF + m * 16;
                const size_t off = (size_t)row * 2048 + col0;
                float ss = 0.f;
#pragma unroll
                for (int bj = 0; bj < 2; ++bj) {
                    f32x4 o0 = *(const f32x4*)(base + off + bj * HALF), o1 = *(const f32x4*)(base + off + bj * HALF + 4);
                    o0 += acc[ai][bj][m][0]; o1 += acc[ai][bj][m][1];
                    *(f32x4*)(out + off + bj * HALF) = o0; *(f32x4*)(out + off + bj * HALF + 4) = o1;
                    ss += ((o0[0] * o0[0] + o0[1] * o0[1]) + (o0[2] * o0[2] + o0[3] * o0[3])) + ((o1[0] * o1[0] + o1[1] * o1[1]) + (o1[2] * o1[2] + o1[3] * o1[3]));
                    u32x4 w; w.x = cvt_pk_bf16(o0[0], o0[1]); w.y = cvt_pk_bf16(o0[2], o0[3]); w.z = cvt_pk_bf16(o1[0], o1[1]); w.w = cvt_pk_bf16(o1[2], o1[3]);
                    *(u32x4*)(xb + off + bj * HALF) = w;
                }
                ss += __shfl_xor(ss, 16); ss += __shfl_xor(ss, 32);
                if (fq == 0) rowss[(size_t)row * 32 + u.pn * 4 + wc] = ss;
                if (m & 1) asm volatile("" ::: "memory");
            }
    }
};
}

__device__ __forceinline__ void p0_transpose_item(const float* __restrict__ W, int K, int N, const float* __restrict__ gain, bf16_t* __restrict__ WT, int kind, LAS float* scr, int item, int lane) {
    const int nblk = (kind == 1) ? (PROJ_P / 64) : (N / 64);
    const int kb = item / nblk, nb = item % nblk, k0 = 64 * kb, n0 = 64 * nb;
    int src0 = n0, nvalid = 64;
    if (kind == 1) { if (n0 < 3584) { src0 = n0; } else if (n0 < 5120) { src0 = n0 + 16; } else if (n0 == 5120) { src0 = 3584; nvalid = 16; } else { src0 = 0; nvalid = 0; } }
    const int c4 = (lane & 15) * 4;
#pragma unroll 4
    for (int i = 0; i < 16; ++i) {
        const int kk = 4 * i + (lane >> 4);
        f32x4 v = (f32x4){0.f, 0.f, 0.f, 0.f};
        if (c4 < nvalid) v = *(const f32x4*)(W + (size_t)(k0 + kk) * N + src0 + c4);
        const float g = gain ? gain[k0 + kk] : 1.0f;
        LAS float* d = scr + kk * 65 + c4;
        d[0] = v[0] * g; d[1] = v[1] * g; d[2] = v[2] * g; d[3] = v[3] * g;
    }
    LDS_WAIT();
    const int c = lane & 7;
#pragma unroll
    for (int j = 0; j < 8; ++j) {
        const int n = 8 * j + (lane >> 3);
        const LAS float* s = scr + (8 * c) * 65 + n;
        u32x4 o; o.x = pk2(s[0 * 65], s[1 * 65]); o.y = pk2(s[2 * 65], s[3 * 65]); o.z = pk2(s[4 * 65], s[5 * 65]); o.w = pk2(s[6 * 65], s[7 * 65]);
        *(u32x4*)(WT + (size_t)(n0 + n) * K + k0 + 8 * c) = o;
    }
    LDS_WAIT();
}

__device__ __forceinline__ void swa_naive_item(const bf16_t* __restrict__ proj, const float* __restrict__ sinks, const float* __restrict__ relb, float* __restrict__ Oa, int t, int hq, LAS float* qs, int lane) {
    const int hk = hq / 3;
    LDS_WAIT();
    qs[lane] = bf2f(proj[(size_t)t * PROJ_P + C_AQ + hq * 64 + lane]);
    LDS_WAIT();
    float logit[2];
#pragma unroll
    for (int e = 0; e < 2; ++e) {
        const int dist = lane + 64 * e, s = t - dist;
        float acc = 0.f;
        if (s >= 0) {
            const u32x4* kr = (const u32x4*)(proj + (size_t)s * PROJ_P + C_AK + hk * 64);
#pragma unroll
            for (int c = 0; c < 8; ++c) {
                const u32x4 kv = kr[c];
                const f32x4 a = *(const LAS f32x4*)(qs + 8 * c), b = *(const LAS f32x4*)(qs + 8 * c + 4);
                acc += bflo(kv.x) * a[0] + bfhi(kv.x) * a[1] + bflo(kv.y) * a[2] + bfhi(kv.y) * a[3] + bflo(kv.z) * b[0] + bfhi(kv.z) * b[1] + bflo(kv.w) * b[2] + bfhi(kv.w) * b[3];
            }
            logit[e] = acc * 0.125f + relb[(int)T5B[dist] * 12 + hq];
        } else logit[e] = -1e30f;
    }
    const float sink = sinks[hq];
    float m = wave_max(fmaxf(logit[0], logit[1])); m = fmaxf(m, sink);
    const float e0 = (t - lane >= 0) ? __expf(logit[0] - m) : 0.f, e1 = (t - lane - 64 >= 0) ? __expf(logit[1] - m) : 0.f;
    const float den = wave_sum(e0 + e1) + __expf(sink - m);
    const float p0 = e0 / den, p1 = e1 / den;
    float o = 0.f;
    const bf16_t* vcol = proj + C_AV + hk * 64 + lane;
    for (int i = 0; i < 64; ++i) { const float pi = __shfl(p0, i); const int s = t - i; if (s >= 0) o += pi * bf2f(vcol[(size_t)s * PROJ_P]); }
    for (int i = 0; i < 64; ++i) { const float pi = __shfl(p1, i); const int s = t - 64 - i; if (s >= 0) o += pi * bf2f(vcol[(size_t)s * PROJ_P]); }
    Oa[(size_t)t * 768 + hq * 64 + lane] = o;
}
__device__ __forceinline__ void sb_naive_item(const bf16_t* __restrict__ proj, float* __restrict__ Oc, int t, int h, LAS float* qs, int lane) {
    LDS_WAIT();
    qs[lane] = bf2f(proj[(size_t)t * PROJ_P + C_CQ + h * 64 + lane]);
    LDS_WAIT();
    float R = 0.f, o = 0.f;
    const bf16_t* vcol = proj + C_CV + h * 64 + lane;
    for (int s_hi = t - 1; s_hi >= 0; s_hi -= 64) {
        const int s = s_hi - lane;
        float z = 0.f, L = 0.f;
        if (s >= 0) {
            const u32x4* kr = (const u32x4*)(proj + (size_t)s * PROJ_P + C_CK + h * 64);
            float acc = 0.f;
#pragma unroll
            for (int c = 0; c < 8; ++c) {
                const u32x4 kv = kr[c];
                const f32x4 a = *(const LAS f32x4*)(qs + 8 * c), b = *(const LAS f32x4*)(qs + 8 * c + 4);
                acc += bflo(kv.x) * a[0] + bfhi(kv.x) * a[1] + bflo(kv.y) * a[2] + bfhi(kv.y) * a[3] + bflo(kv.z) * b[0] + bfhi(kv.z) * b[1] + bflo(kv.w) * b[2] + bfhi(kv.w) * b[3];
            }
            z = acc * 0.125f; L = -softplusf(z);
        }
        const float C = R + wave_incl_scan(L, lane);
        const float w = (s >= 0) ? __expf(z + C) : 0.f;
        R = __shfl(C, 63);
        const int nk = (s_hi + 1 < 64) ? (s_hi + 1) : 64;
        for (int i = 0; i < nk; ++i) { const float wi = __shfl(w, i); o += wi * bf2f(vcol[(size_t)(s_hi - i) * PROJ_P]); }
        if (R < -105.0f) break;
    }
    Oc[(size_t)t * 512 + h * 64 + lane] = o;
}
__device__ __forceinline__ void gla_seq_item(const bf16_t* __restrict__ proj, const float* __restrict__ lgate, float* __restrict__ Ob, int h, int j, int lane) {
    float s0 = 0.f, s1 = 0.f;
    const bool two = lane < 32;
    const int kA = h * 96 + lane, kB = h * 96 + 64 + (lane & 31);
    for (int t0 = 0; t0 < SEQ; t0 += 8) {
        float g0[8], k0[8], q0[8], g1[8], k1[8], q1[8], vv[8];
#pragma unroll
        for (int u = 0; u < 8; ++u) {
            const bf16_t* row = proj + (size_t)(t0 + u) * PROJ_P; const float* lg = lgate + (size_t)(t0 + u) * 384;
            g0[u] = lg[kA]; k0[u] = bf2f(row[C_BK + kA]); q0[u] = bf2f(row[C_BQ + kA]);
            g1[u] = lg[kB]; k1[u] = bf2f(row[C_BK + kB]); q1[u] = bf2f(row[C_BQ + kB]);
            vv[u] = bf2f(row[C_BV + h * 192 + j]);
        }
#pragma unroll
        for (int u = 0; u < 8; ++u) {
            s0 = __expf(g0[u]) * s0 + k0[u] * vv[u];
            s1 = __expf(g1[u]) * s1 + k1[u] * vv[u];
            float a = q0[u] * s0 + (two ? q1[u] * s1 : 0.f);
            a = wave_sum(a);
            if (lane == 0) Ob[(size_t)(t0 + u) * 768 + h * 192 + j] = a * 0.10206207261596577f;
        }
    }
}
__device__ __forceinline__ void norm_mixed_row(const float* __restrict__ Oa, const float* __restrict__ Ob, const float* __restrict__ Oc, const bf16_t* __restrict__ proj,
                                               const float* __restrict__ gA, const float* __restrict__ gB, const float* __restrict__ gC, bf16_t* __restrict__ mixed, int t, int lane) {
    bf16_t* mrow = mixed + (size_t)t * 2048;
    {
        float a[12], ss = 0.f;
#pragma unroll
        for (int i = 0; i < 12; ++i) { a[i] = Oa[(size_t)t * 768 + lane + 64 * i]; ss += a[i] * a[i]; }
        const float r = rsqrtf(wave_sum(ss) * (1.0f / 768.0f) + RMS_EPS);
#pragma unroll
        for (int i = 0; i < 12; ++i) mrow[lane + 64 * i] = (bf16_t)f2bf(a[i] * r * gA[lane + 64 * i]);
    }
#pragma unroll
    for (int h = 0; h < 4; ++h) {
        float b[3], ss = 0.f;
#pragma unroll
        for (int i = 0; i < 3; ++i) { b[i] = Ob[(size_t)t * 768 + h * 192 + lane + 64 * i]; ss += b[i] * b[i]; }
        const float r = rsqrtf(wave_sum(ss) * (1.0f / 192.0f) + RMS_EPS);
#pragma unroll
        for (int i = 0; i < 3; ++i) {
            const int c = lane + 64 * i;
            const float br = bf2f(proj[(size_t)t * PROJ_P + C_BR + h * 192 + c]);
            const float y = b[i] * r * gB[c] * (br / (1.0f + __expf(-br)));
            mrow[768 + h * 192 + c] = (bf16_t)f2bf(y);
        }
    }
    {
        float a[8], ss = 0.f;
#pragma unroll
        for (int i = 0; i < 8; ++i) { a[i] = Oc[(size_t)t * 512 + lane + 64 * i]; ss += a[i] * a[i]; }
        const float r = rsqrtf(wave_sum(ss) * (1.0f / 512.0f) + RMS_EPS);
#pragma unroll
        for (int i = 0; i < 8; ++i) mrow[1536 + lane + 64 * i] = (bf16_t)f2bf(a[i] * r * gC[lane + 64 * i]);
    }
}


typedef short bf16x8 __attribute__((ext_vector_type(8)));
typedef short s16x4 __attribute__((ext_vector_type(4)));
__device__ __forceinline__ f32x4 mfma16(bf16x8 a, bf16x8 b, f32x4 c) { return __builtin_amdgcn_mfma_f32_16x16x32_bf16(a, b, c, 0, 0, 0); }
__device__ __forceinline__ bf16x8 lds_frag_row(const LAS unsigned char* base, int stride, int r0, int k0, int lane) {
    return *(const LAS bf16x8*)(base + (r0 + (lane & 15)) * stride + (k0 + 8 * (lane >> 4)) * 2);
}
__device__ __forceinline__ bf16x8 lds_frag_tr(const LAS unsigned char* base, int stride, int k0, int c0, int lane) {
    const int g = lane >> 4, i = lane & 15;
    const LAS unsigned char* p = base + (k0 + 8 * g + (i >> 2)) * stride + (c0 + 4 * (i & 3)) * 2;
    const s16x4 lo = __builtin_bit_cast(s16x4, __builtin_amdgcn_ds_read_tr16_b64_v4i16((LAS s16x4*)p));
    const s16x4 hi = __builtin_bit_cast(s16x4, __builtin_amdgcn_ds_read_tr16_b64_v4i16((LAS s16x4*)(p + 4 * stride)));
    return (bf16x8){lo[0], lo[1], lo[2], lo[3], hi[0], hi[1], hi[2], hi[3]};
}

constexpr int GL_LG = 0, GL_QD = 24832, GL_KI = 38144, GL_KE = 51456, GL_VS = 64768, GL_SC = 90368, GL_BLR = 99584, GL_GW = 103680, GL_BL = 109824;
__device__ __forceinline__ void gla_local_item(LAS unsigned char* lds, const bf16_t* __restrict__ proj, const float* __restrict__ gwt  , const float* __restrict__ gbs  ,
                                               float* __restrict__ Ob, float* __restrict__ dstate, float* __restrict__ decay, bf16_t* __restrict__ qdec, int n, int h, int tid) {
    const int lane = tid & 63, wave = __builtin_amdgcn_readfirstlane(tid >> 6), g4 = lane >> 4, l15 = lane & 15;
    const int t0 = 64 * n;
    LAS float* lg = (LAS float*)(lds + GL_LG); LAS float* blr = (LAS float*)(lds + GL_BLR); LAS float* gw = (LAS float*)(lds + GL_GW); LAS float* bl = (LAS float*)(lds + GL_BL);
    if (tid < 128) {
        const int row = tid >> 1, half = tid & 1;
        const u32x4 v = *(const u32x4*)(proj + (size_t)(t0 + row) * PROJ_P + C_LR + 8 * half);
        LAS float* d = blr + row * 16 + 8 * half;
        d[0] = bflo(v.x); d[1] = bfhi(v.x); d[2] = bflo(v.y); d[3] = bfhi(v.y); d[4] = bflo(v.z); d[5] = bfhi(v.z); d[6] = bflo(v.w); d[7] = bfhi(v.w);
    }
    for (int i = tid; i < 16 * 96; i += NTHREADS) { const int r = i / 96, c = i % 96; gw[i] = gwt[r * 384 + h * 96 + c]; }
#pragma unroll
    for (int i = 0; i < 3; ++i) {
        const int id = tid + NTHREADS * i, row = id / 24, ch = id % 24;
        const u32x4 v = *(const u32x4*)(proj + (size_t)(t0 + row) * PROJ_P + C_BV + h * 192 + 8 * ch);
        *(LAS u32x4*)(lds + GL_VS + row * 400 + ch * 16) = v;
    }
    __syncthreads();
    for (int i = tid; i < 64 * 96; i += NTHREADS) {
        const int t = i / 96, k = i % 96;
        float gp = gbs[h * 96 + k];
#pragma unroll
        for (int r = 0; r < 16; ++r) gp += blr[t * 16 + r] * gw[r * 96 + k];
        const float ls = fminf(gp, 0.f) - log1pf(__expf(-fabsf(gp)));
        lg[t * 97 + k] = fmaxf(ls * (1.0f / 16.0f), -1.0f);
    }
    __syncthreads();
    if (tid < 384) {
        const int k = tid >> 2, part = tid & 3;
        float run = 0.f;
#pragma unroll
        for (int i = 0; i < 16; ++i) { run += lg[(16 * part + i) * 97 + k]; lg[(16 * part + i) * 97 + k] = run; }
        const float o1 = __shfl_up(run, 1), o2 = __shfl_up(run, 2), o3 = __shfl_up(run, 3);
        const float off = (part >= 1 ? o1 : 0.f) + (part >= 2 ? o2 : 0.f) + (part >= 3 ? o3 : 0.f);
#pragma unroll
        for (int i = 0; i < 16; ++i) lg[(16 * part + i) * 97 + k] += off;
        if (part == 3) bl[k] = run + off;
    }
    __syncthreads();
    for (int i = tid; i < 64 * 96; i += NTHREADS) {
        const int t = i / 96, k = i % 96;
        const float b = lg[t * 97 + k];
        const bf16_t* row = proj + (size_t)(t0 + t) * PROJ_P;
        const float q = bf2f(row[C_BQ + h * 96 + k]), kk = bf2f(row[C_BK + h * 96 + k]);
        const unsigned qd = f2bf(q * 0.10206207261596577f * __expf(b)), ki = f2bf(kk * __expf(-b)), ke = f2bf(kk * __expf(bl[k] - b));
        *(LAS bf16_t*)(lds + GL_QD + t * 208 + k * 2) = (bf16_t)qd;
        *(LAS bf16_t*)(lds + GL_KI + t * 208 + k * 2) = (bf16_t)ki;
        *(LAS bf16_t*)(lds + GL_KE + t * 208 + k * 2) = (bf16_t)ke;
        qdec[(size_t)(t0 + t) * 384 + h * 96 + k] = (bf16_t)qd;
    }
    if (tid < 96) decay[(n * 4 + h) * 96 + tid] = __expf(bl[tid]);
    __syncthreads();
    {
        const int rt = wave >> 1;
        f32x4 acc[2] = {(f32x4){0.f, 0.f, 0.f, 0.f}, (f32x4){0.f, 0.f, 0.f, 0.f}};
#pragma unroll
        for (int ks = 0; ks < 3; ++ks) {
            const bf16x8 a = lds_frag_row(lds + GL_QD, 208, 16 * rt, 32 * ks, lane);
#pragma unroll
            for (int c = 0; c < 2; ++c) { const bf16x8 b = lds_frag_row(lds + GL_KI, 208, 16 * (2 * (wave & 1) + c), 32 * ks, lane); acc[c] = mfma16(a, b, acc[c]); }
        }
#pragma unroll
        for (int c = 0; c < 2; ++c) {
            const int s = 16 * (2 * (wave & 1) + c) + l15;
#pragma unroll
            for (int i = 0; i < 4; ++i) { const int t = 16 * rt + 4 * g4 + i; *(LAS bf16_t*)(lds + GL_SC + t * 144 + s * 2) = (bf16_t)f2bf(s <= t ? acc[c][i] : 0.f); }
        }
    }
    __syncthreads();
    {
        const int rt = wave >> 1;
        const bf16x8 a0 = lds_frag_row(lds + GL_SC, 144, 16 * rt, 0, lane), a1 = lds_frag_row(lds + GL_SC, 144, 16 * rt, 32, lane);
#pragma unroll
        for (int c = 0; c < 6; ++c) {
            const int ct = 6 * (wave & 1) + c;
            const bf16x8 b0 = lds_frag_tr(lds + GL_VS, 400, 0, 16 * ct, lane), b1 = lds_frag_tr(lds + GL_VS, 400, 32, 16 * ct, lane);
            f32x4 acc = mfma16(a0, b0, (f32x4){0.f, 0.f, 0.f, 0.f}); acc = mfma16(a1, b1, acc);
#pragma unroll
            for (int i = 0; i < 4; ++i) Ob[(size_t)(t0 + 16 * rt + 4 * g4 + i) * 768 + h * 192 + 16 * ct + l15] = acc[i];
        }
#pragma unroll
        for (int c = 0; c < 9; ++c) {
            const int T = wave * 9 + c, kt = T / 12, ct = T % 12;
            const bf16x8 a0 = lds_frag_tr(lds + GL_KE, 208, 0, 16 * kt, lane), a1 = lds_frag_tr(lds + GL_KE, 208, 32, 16 * kt, lane);
            const bf16x8 b0 = lds_frag_tr(lds + GL_VS, 400, 0, 16 * ct, lane), b1 = lds_frag_tr(lds + GL_VS, 400, 32, 16 * ct, lane);
            f32x4 acc = mfma16(a0, b0, (f32x4){0.f, 0.f, 0.f, 0.f}); acc = mfma16(a1, b1, acc);
            *(f32x4*)(dstate + ((size_t)(n * 4 + h) * 192 + 16 * ct + l15) * 96 + 16 * kt + 4 * g4) = acc;
        }
    }
    __syncthreads();
}
__device__ __forceinline__ void gla_scan_elem(const float* __restrict__ dstate, const float* __restrict__ decay, bf16_t* __restrict__ sprev, int e) {
    const int h = e / 18432, dk = e % 96;
    float S = 0.f;
    for (int n0 = 0; n0 < 128; n0 += 8) {
        float ds[8], dc[8];
#pragma unroll
        for (int u = 0; u < 8; ++u) { ds[u] = dstate[(size_t)(n0 + u) * 73728 + e]; dc[u] = decay[((n0 + u) * 4 + h) * 96 + dk]; }
#pragma unroll
        for (int u = 0; u < 8; ++u) { sprev[(size_t)(n0 + u) * 73728 + e] = (bf16_t)f2bf(S); S = dc[u] * S + ds[u]; }
    }
}
__device__ __forceinline__ void gla_out_item(LAS unsigned char* lds, const bf16_t* __restrict__ proj, const bf16_t* __restrict__ qdec, const bf16_t* __restrict__ sprev, const float* __restrict__ Ob,
                                             const float* __restrict__ gB, bf16_t* __restrict__ mixed, int n, int h, int tid) {
    const int lane = tid & 63, wave = __builtin_amdgcn_readfirstlane(tid >> 6), g4 = lane >> 4, l15 = lane & 15;
    const int t0 = 64 * n, rt = wave >> 1;
    LAS float* ssx = (LAS float*)lds;
    bf16x8 a[3];
#pragma unroll
    for (int ks = 0; ks < 3; ++ks) a[ks] = *(const bf16x8*)(qdec + (size_t)(t0 + 16 * rt + l15) * 384 + h * 96 + 32 * ks + 8 * g4);
    f32x4 o[6]; float ss[4] = {0.f, 0.f, 0.f, 0.f};
#pragma unroll
    for (int c = 0; c < 6; ++c) {
        const int dv = 16 * (6 * (wave & 1) + c) + l15;
        const bf16_t* sp = sprev + ((size_t)(n * 4 + h) * 192 + dv) * 96 + 8 * g4;
        f32x4 acc = (f32x4){0.f, 0.f, 0.f, 0.f};
#pragma unroll
        for (int ks = 0; ks < 3; ++ks) acc = mfma16(a[ks], *(const bf16x8*)(sp + 32 * ks), acc);
#pragma unroll
        for (int i = 0; i < 4; ++i) { acc[i] += Ob[(size_t)(t0 + 16 * rt + 4 * g4 + i) * 768 + h * 192 + dv]; ss[i] += acc[i] * acc[i]; }
        o[c] = acc;
    }
#pragma unroll
    for (int i = 0; i < 4; ++i) {
        float s = ss[i];
        s += __shfl_xor(s, 1); s += __shfl_xor(s, 2); s += __shfl_xor(s, 4); s += __shfl_xor(s, 8);
        if (l15 == 0) ssx[(16 * rt + 4 * g4 + i) * 2 + (wave & 1)] = s;
    }
    __syncthreads();
    float r[4];
#pragma unroll
    for (int i = 0; i < 4; ++i) { const int row = 16 * rt + 4 * g4 + i; r[i] = rsqrtf((ssx[row * 2] + ssx[row * 2 + 1]) * (1.0f / 192.0f) + RMS_EPS); }
#pragma unroll
    for (int c = 0; c < 6; ++c) {
        const int dv = 16 * (6 * (wave & 1) + c) + l15;
        const float gn = gB[dv];
#pragma unroll
        for (int i = 0; i < 4; ++i) {
            const int t = t0 + 16 * rt + 4 * g4 + i;
            const float br = bf2f(proj[(size_t)t * PROJ_P + C_BR + h * 192 + dv]);
            mixed[(size_t)t * 2048 + 768 + h * 192 + dv] = (bf16_t)f2bf(o[c][i] * r[i] * gn * (br / (1.0f + __expf(-br))));
        }
    }
    __syncthreads();
}
__device__ __forceinline__ void norm_ac_row(const float* __restrict__ Oa, const float* __restrict__ Oc, const float* __restrict__ gA, const float* __restrict__ gC, bf16_t* __restrict__ mixed, int t, int lane) {
    bf16_t* mrow = mixed + (size_t)t * 2048;
    {
        float a[12], ss = 0.f;
#pragma unroll
        for (int i = 0; i < 12; ++i) { a[i] = Oa[(size_t)t * 768 + lane + 64 * i]; ss += a[i] * a[i]; }
        const float r = rsqrtf(wave_sum(ss) * (1.0f / 768.0f) + RMS_EPS);
#pragma unroll
        for (int i = 0; i < 12; ++i) mrow[lane + 64 * i] = (bf16_t)f2bf(a[i] * r * gA[lane + 64 * i]);
    }
    {
        float a[8], ss = 0.f;
#pragma unroll
        for (int i = 0; i < 8; ++i) { a[i] = Oc[(size_t)t * 512 + lane + 64 * i]; ss += a[i] * a[i]; }
        const float r = rsqrtf(wave_sum(ss) * (1.0f / 512.0f) + RMS_EPS);
#pragma unroll
        for (int i = 0; i < 8; ++i) mrow[1536 + lane + 64 * i] = (bf16_t)f2bf(a[i] * r * gC[lane + 64 * i]);
    }
}

#ifndef PH_MASK
#define PH_MASK 0x1ff
#endif
#define HAS(k) (((PH_MASK) >> (k)) & 1)
struct Params { const float* in[15]; float* out; unsigned char* ws; int ph_lo, ph_hi; };
constexpr int N_PHASES = 16;

__global__ void __launch_bounds__(NTHREADS, 2) mega(Params p) {
    extern __shared__ __attribute__((aligned(16))) unsigned char lds_raw[];
    LAS unsigned char* lds = (LAS unsigned char*)lds_raw;
    cg::grid_group grid = cg::this_grid();
    const int G = gridDim.x;
    unsigned char* ws = p.ws;
    const float* x_in = p.in[0];
    float* xres = p.out;
    bf16_t* xb = (bf16_t*)(ws + WS_XB);
    float* rowss = (float*)(ws + WS_ROWSS);
    bf16_t* proj = (bf16_t*)(ws + WS_PROJ);
    float* Oa = (float*)(ws + WS_OA); float* Ob = (float*)(ws + WS_OB); float* Oc = (float*)(ws + WS_OC);
    float* dstate = (float*)(ws + WS_DSTATE); float* decay = (float*)(ws + WS_DECAY); bf16_t* sprev = (bf16_t*)(ws + WS_SPREV); bf16_t* qdec = (bf16_t*)(ws + WS_QDEC);
    bf16_t* mixed = (bf16_t*)(ws + WS_MIXED);
    bf16_t* hid = (bf16_t*)(ws + WS_HID);
#define IN(k) (p.ph_lo <= (k) && (k) < p.ph_hi)
#define SYNC(k) do { if (IN(k) && IN((k) + 1)) grid.sync(); } while (0)
#define PHASE_IDS() int tid = threadIdx.x; asm volatile("" : "+v"(tid)); const int lane = tid & 63, wave = __builtin_amdgcn_readfirstlane(tid >> 6), gw = blockIdx.x * NWAVES + wave, NGW = G * NWAVES; (void)lane; (void)gw; (void)NGW

    if (HAS(0) && IN(0)) {
        PHASE_IDS();
        LAS float* scr = (LAS float*)(lds + wave * 16640);
        constexpr int I_IN = 32 * (PROJ_P / 64), I_OUT = 32 * 32, I_1 = 32 * 128, I_2 = 128 * 32, I_L = I_IN + I_OUT + I_1 + I_2;
        for (int it = gw; it < DEPTH * I_L; it += NGW) {
            const int l = it / I_L; int r = it % I_L;
            unsigned char* wt = ws + WS_WT + (size_t)l * WT_LAYER;
            if (r < I_IN) { p0_transpose_item(p.in[2] + (size_t)l * DM * PROJ_W, DM, PROJ_W, p.in[1] + l * DM, (bf16_t*)(wt + WT_IN), 1, scr, r, lane); continue; } r -= I_IN;
            if (r < I_OUT) { p0_transpose_item(p.in[10] + (size_t)l * DM * DM, DM, DM, nullptr, (bf16_t*)(wt + WT_OUT), 0, scr, r, lane); continue; } r -= I_OUT;
            if (r < I_1) { p0_transpose_item(p.in[12] + (size_t)l * DM * DFF, DM, DFF, p.in[11] + l * DM, (bf16_t*)(wt + WT_1), 0, scr, r, lane); continue; } r -= I_1;
            p0_transpose_item(p.in[13] + (size_t)l * DFF * DM, DFF, DM, nullptr, (bf16_t*)(wt + WT_2), 0, scr, r, lane);
        }
        for (int m = gw; m < SEQ; m += NGW) {
            const f32x4* xr = (const f32x4*)(x_in + (size_t)m * DM) + lane;
            f32x4 v[8]; float ss = 0.f;
#pragma unroll
            for (int j = 0; j < 8; ++j) { v[j] = xr[64 * j]; ss += (v[j][0] * v[j][0] + v[j][1] * v[j][1]) + (v[j][2] * v[j][2] + v[j][3] * v[j][3]); }
            ss = wave_sum(ss);
            u32x2* o8 = (u32x2*)(xb + (size_t)m * DM) + lane;
#pragma unroll
            for (int j = 0; j < 8; ++j) { u32x2 w; w.x = pk2(v[j][0], v[j][1]); w.y = pk2(v[j][2], v[j][3]); o8[64 * j] = w; }
            if (lane < 32) rowss[(size_t)m * 32 + lane] = (lane == 0) ? ss : 0.f;
        }
    }
    SYNC(0);
    for (int l = 0; l < DEPTH; ++l) {
        const int pb = 1 + 7 * l;
        unsigned char* wt = ws + WS_WT + (size_t)l * WT_LAYER;
        if (HAS(1) && IN(pb + 0)) {
            pg8::Gemm g{xb, (const bf16_t*)(wt + WT_IN), SEQ, PROJ_P, DM}; pg8::StaticOrder S; S.init(SEQ, PROJ_P, G, (int)blockIdx.x);
            pg8::EpiScale<0> E{proj, PROJ_P, rowss};
            pg8::gemm_phase<pg8::EpiScale<0>, pg8::StaticOrder, true, true>(lds, g, S, E);
        }
        SYNC(pb + 0);
        if (HAS(2) && IN(pb + 1)) {
            PHASE_IDS();
            const float* gwt = p.in[5] + (size_t)l * 16 * 384; const float* gbs = p.in[6] + l * 384;
            for (int it = blockIdx.x; it < 512; it += G) gla_local_item(lds, proj, gwt, gbs, Ob, dstate, decay, qdec, it >> 2, it & 3, tid);
            LAS float* qs = (LAS float*)lds + wave * 64;
            const float* sinks = p.in[3] + l * 12; const float* relb = p.in[4];
            for (int it = gw; it < SEQ * 12; it += NGW) swa_naive_item(proj, sinks, relb, Oa, it / 12, it % 12, qs, lane);
            for (int it = gw; it < SEQ * 8; it += NGW) sb_naive_item(proj, Oc, it / 8, it % 8, qs, lane);
        }
        SYNC(pb + 1);
        if (HAS(3) && IN(pb + 2)) {
            PHASE_IDS();
            const int per = (73728 + G - 1) / G, e1 = min((int)(blockIdx.x + 1) * per, 73728);
            for (int e = blockIdx.x * per + tid; e < e1; e += NTHREADS) gla_scan_elem(dstate, decay, sprev, e);
        }
        SYNC(pb + 2);
        if (HAS(4) && IN(pb + 3)) {
            PHASE_IDS();
            const float* gA = p.in[8] + l * 768; const float* gB = p.in[7] + l * 192; const float* gC = p.in[9] + l * 512;
            for (int it = blockIdx.x; it < 512; it += G) gla_out_item(lds, proj, qdec, sprev, Ob, gB, mixed, it >> 2, it & 3, tid);
            for (int t = gw; t < SEQ; t += NGW) norm_ac_row(Oa, Oc, gA, gC, mixed, t, lane);
        }
        SYNC(pb + 3);
        if (HAS(5) && IN(pb + 4)) {
            pg8::Gemm g{mixed, (const bf16_t*)(wt + WT_OUT), SEQ, DM, DM}; pg8::StaticOrder S; S.init(SEQ, DM, G, (int)blockIdx.x);
            pg8::EpiResid E{l == 0 ? x_in : xres, xres, xb, rowss};
            pg8::gemm_phase<pg8::EpiResid, pg8::StaticOrder, true, true>(lds, g, S, E);
        }
        SYNC(pb + 4);
        if (HAS(6) && IN(pb + 5)) {
            pg8::Gemm g{xb, (const bf16_t*)(wt + WT_1), SEQ, DFF, DM}; pg8::StaticOrder S; S.init(SEQ, DFF, G, (int)blockIdx.x);
            pg8::EpiScale<1> E{hid, DFF, rowss};
            pg8::gemm_phase<pg8::EpiScale<1>, pg8::StaticOrder, true, true>(lds, g, S, E);
        }
        SYNC(pb + 5);
        if (HAS(7) && IN(pb + 6)) {
            pg8::Gemm g{hid, (const bf16_t*)(wt + WT_2), SEQ, DM, DFF}; pg8::StaticOrder S; S.init(SEQ, DM, G, (int)blockIdx.x);
            pg8::EpiResid E{xres, xres, xb, rowss};
            pg8::gemm_phase<pg8::EpiResid, pg8::StaticOrder, true, true>(lds, g, S, E);
        }
        SYNC(pb + 6);
    }
    if (HAS(8) && IN(N_PHASES - 1)) {
        PHASE_IDS();
        const float* gF = p.in[14];
        for (int m = gw; m < SEQ; m += NGW) {
            const float part = (lane < 32) ? rowss[(size_t)m * 32 + lane] : 0.f;
            const float rstd = rsqrtf(wave_sum(part) * (1.0f / 2048.0f) + RMS_EPS);
            f32x4* xr = (f32x4*)(xres + (size_t)m * DM) + lane;
            const f32x4* gr = (const f32x4*)gF + lane;
#pragma unroll
            for (int j = 0; j < 8; ++j) { f32x4 v = xr[64 * j]; const f32x4 g = gr[64 * j]; v = v * rstd * g; xr[64 * j] = v; }
        }
    }
}

#ifndef MK_N_LAUNCHES
#define MK_N_LAUNCHES 1
#endif
extern "C" void kernel_launch(void* const* d_in, const int* in_sizes, int n_in, void* d_out, int out_size, void* d_ws, size_t ws_size, hipStream_t stream) {
    static int grid = 0;
    if (grid == 0) {
        if (n_in != 15 || out_size != SEQ * DM || ws_size < WS_END) { fprintf(stderr, "kernel_launch: unexpected shapes (n_in %d out %d ws %zu)\n", n_in, out_size, ws_size); grid = -1; return; }
        int dev = 0, cus = 0, per_cu = 0;
        hipGetDevice(&dev);
        hipDeviceGetAttribute(&cus, hipDeviceAttributeMultiprocessorCount, dev);
        hipFuncSetAttribute((const void*)mega, hipFuncAttributeMaxDynamicSharedMemorySize, LDS_BYTES);
        hipOccupancyMaxActiveBlocksPerMultiprocessor(&per_cu, (const void*)mega, NTHREADS, LDS_BYTES);
        if (per_cu < 1) { fprintf(stderr, "kernel_launch: occupancy query says %d blocks/CU\n", per_cu); per_cu = 1; }
        (void)hipGetLastError();
        grid = cus * 1;
    }
    if (grid < 0) return;
    Params p{};
    for (int i = 0; i < 15; ++i) p.in[i] = (const float*)d_in[i];
    p.out = (float*)d_out; p.ws = (unsigned char*)d_ws;
    if (MK_N_LAUNCHES == 1) {
        p.ph_lo = 0; p.ph_hi = N_PHASES;
        void* args[] = {&p};
        hipError_t e = hipLaunchCooperativeKernel((const void*)mega, dim3(grid), dim3(NTHREADS), args, LDS_BYTES, stream);
        if (e != hipSuccess) fprintf(stderr, "cooperative launch failed: %s (grid %d)\n", hipGetErrorString(e), grid);
    } else {
        for (int ph = 0; ph < N_PHASES; ++ph) {
            p.ph_lo = ph; p.ph_hi = ph + 1;
            hipLaunchKernelGGL(mega, dim3(grid), dim3(NTHREADS), LDS_BYTES, stream, p);
        }
    }
}
```

```cpp
#include <hip/hip_runtime.h>
#include <hip/hip_cooperative_groups.h>
#include <cstdio>
#include <cstdint>
namespace cg = cooperative_groups;
namespace pg8 {
#define PG8_LAS __attribute__((address_space(3)))
typedef unsigned short bf16_t;
typedef short bf16x8 __attribute__((ext_vector_type(8)));
typedef float f32x4 __attribute__((ext_vector_type(4)));
typedef unsigned u32x4 __attribute__((ext_vector_type(4)));
constexpr int BM = 256, BK = 64, HALF = 128, HTB = HALF * BK * 2  , STAGE_BYTES = 8 * HTB, NXCD = 8, WGM = 8;

__host__ __device__ __forceinline__ int lds_byte(int r, int c) { const int st = (r >> 4) * 2 + (c >> 5), rr = r & 15, cc = c & 31, ob = rr * 64 + cc * 2; return st * 1024 + (ob ^ (((ob >> 9) & 1) << 5)); }
__host__ __device__ __forceinline__ void stage_rc(int b, int& R, int& C) { const int st = b / 1024, sb = b % 1024, swz = sb ^ (((sb >> 9) & 1) << 5); R = (st >> 1) * 16 + swz / 64; C = (st & 1) * 32 + (swz % 64) / 2; }
__host__ __device__ __forceinline__ int perm32(int rho) { const int n = rho >> 4, i = rho & 15; return 8 * (i >> 2) + 4 * n + (i & 3); }

struct Unit { int pm, pn; };
struct Gemm { const bf16_t* A; const bf16_t* Bt; int M, N, K; };

struct StaticOrder {
    int nM, nN, nwg, G, c;
    __host__ __device__ void init(int M, int N, int G_, int c_) { nM = M / BM; nN = N / BM; nwg = nM * nN; G = G_; c = c_; }
    __host__ __device__ bool next(int i, Unit& u) const {
        const long L = (long)i * G + c; if (L >= nwg) return false;
        int wgid = (int)L; { const int q = nwg / NXCD, r = nwg % NXCD, xcd = wgid % NXCD, off = wgid / NXCD; wgid = (xcd < r ? xcd * (q + 1) : r * (q + 1) + (xcd - r) * q) + off; }
        const int nig = WGM * nN, gid = wgid / nig, fm = gid * WGM, gsz = (nM - fm) < WGM ? (nM - fm) : WGM;
        u.pm = fm + ((wgid % nig) % gsz); u.pn = (wgid % nig) / gsz; return true;
    }
    __device__ __forceinline__ void a_ready(const Unit&) const {}
    __device__ __forceinline__ void done(const Unit&) const {}
};
__device__ __forceinline__ unsigned cvt_pk_bf16(float lo, float hi) { unsigned r; asm volatile("v_cvt_pk_bf16_f32 %0, %1, %2" : "=v"(r) : "v"(lo), "v"(hi)); return r; }
typedef float f32x2 __attribute__((ext_vector_type(2)));
template <class Epi, class Sched, bool ALIGN_EPI = false, bool SP2 = false>
__device__ __forceinline__ void gemm_phase(PG8_LAS unsigned char* lds, const Gemm g, const Sched& S, const Epi& E) {
    int tid_ = threadIdx.x; asm volatile("" : "+v"(tid_));
    const int tid = tid_, wid = __builtin_amdgcn_readfirstlane(tid >> 6), lane = tid & 63, wr = wid >> 2, wc = wid & 3, fr = lane & 15, fq = lane >> 4;
    const int K = g.K, nt = K / BK;
    unsigned voffA[2], voffB[2];
#pragma unroll
    for (int i = 0; i < 2; ++i) { int R, C; stage_rc(tid * 16 + i * 8192, R, C); const int Rb = Epi::PERM ? ((R & ~31) + perm32(R & 31)) : R;
        voffA[i] = (unsigned)(R * K + C) * 2u; voffB[i] = (unsigned)(Rb * K + C) * 2u; }
    const size_t kstep = (size_t)(BK * 2);
    const size_t hstep = (size_t)HALF * K * 2;
    const size_t tstep = 2 * hstep;
    const unsigned ldsw = (unsigned)wid * 1024u;
    const int aoff = lds_byte(wr * 64 + fr, fq * 8), boff = lds_byte(wc * 32 + fr, fq * 8);
#define PG8_SA(b, h) (((b) * 2 + (h)) * HTB)
#define PG8_SB(b, h) ((4 + (b) * 2 + (h)) * HTB)
#define PG8_STAGE(bufoff, gbase, voff) do { _Pragma("unroll") for (int _i = 0; _i < 2; ++_i) \
        __builtin_amdgcn_global_load_lds((const unsigned*)((const char*)(gbase) + (voff)[_i]), (PG8_LAS unsigned*)(lds + (bufoff) + ldsw + _i * 8192), 16, 0, 0); } while (0)
#define PG8_LDA(dst, b, h) do { _Pragma("unroll") for (int m = 0; m < 4; ++m) _Pragma("unroll") for (int k = 0; k < 2; ++k) dst[m][k] = *(const PG8_LAS bf16x8*)(lds + PG8_SA(b, h) + aoff + m * 2048 + k * 1024); } while (0)
#define PG8_LDB(dst, b, h) do { _Pragma("unroll") for (int n = 0; n < 2; ++n) _Pragma("unroll") for (int k = 0; k < 2; ++k) dst[n][k] = *(const PG8_LAS bf16x8*)(lds + PG8_SB(b, h) + boff + n * 2048 + k * 1024); } while (0)
#define PG8_MMA(ai, bj, At, Bt) do { __builtin_amdgcn_s_setprio(1); _Pragma("unroll") for (int m = 0; m < 4; ++m) _Pragma("unroll") for (int n = 0; n < 2; ++n) _Pragma("unroll") for (int k = 0; k < 2; ++k) \
        acc[ai][bj][m][n] = __builtin_amdgcn_mfma_f32_16x16x32_bf16(Bt[n][k], At[m][k], acc[ai][bj][m][n], 0, 0, 0); __builtin_amdgcn_s_setprio(0); } while (0)
#define PG8_WAIT_V(n) asm volatile("s_waitcnt vmcnt(" #n ")" ::: "memory")
#define PG8_WAIT_L(n) asm volatile("s_waitcnt lgkmcnt(" #n ")" ::: "memory")
#define PG8_BAR __builtin_amdgcn_s_barrier()
#define PG8_SCHED __builtin_amdgcn_sched_barrier(0)
    Unit cur, nxt; int ui = 0;
    if (!S.next(0, cur)) return;
    f32x4 acc[2][2][4][2];
#pragma unroll
    for (int a = 0; a < 2; ++a)
#pragma unroll
        for (int b = 0; b < 2; ++b)
#pragma unroll
            for (int m = 0; m < 4; ++m)
#pragma unroll
                for (int n = 0; n < 2; ++n) acc[a][b][m][n] = (f32x4){0.f, 0.f, 0.f, 0.f};
    bf16x8 At[4][2], B0[2][2], B1[2][2];
    const char* cA = (const char*)g.A + (size_t)cur.pm * tstep; const char* cB = (const char*)g.Bt + (size_t)cur.pn * tstep;
    S.a_ready(cur);
    if constexpr (SP2) {
        PG8_STAGE(PG8_SB(0, 0), cB, voffB); PG8_STAGE(PG8_SB(0, 1), cB + hstep, voffB); PG8_STAGE(PG8_SA(0, 0), cA, voffA); PG8_STAGE(PG8_SA(0, 1), cA + hstep, voffA);
        if (wr == 1) PG8_BAR;
        PG8_WAIT_V(2); PG8_BAR;
        PG8_STAGE(PG8_SB(1, 0), cB + kstep, voffB); PG8_STAGE(PG8_SA(1, 0), cA + kstep, voffA); PG8_STAGE(PG8_SB(1, 1), cB + hstep + kstep, voffB);
        PG8_WAIT_V(6); PG8_BAR;
    } else {
        PG8_STAGE(PG8_SB(0, 0), cB, voffB); PG8_STAGE(PG8_SA(0, 0), cA, voffA); PG8_STAGE(PG8_SB(0, 1), cB + hstep, voffB); PG8_STAGE(PG8_SA(0, 1), cA + hstep, voffA);
        if (wr == 1) PG8_BAR;
        PG8_WAIT_V(4); PG8_BAR;
        PG8_STAGE(PG8_SB(1, 0), cB + kstep, voffB); PG8_STAGE(PG8_SA(1, 0), cA + kstep, voffA); PG8_STAGE(PG8_SB(1, 1), cB + hstep + kstep, voffB);
        PG8_WAIT_V(6); PG8_BAR;
    }
    for (;;) {
        const bool has_next = S.next(ui + 1, nxt);
        const char* nA = has_next ? (const char*)g.A + (size_t)nxt.pm * tstep : cA; const char* nB = has_next ? (const char*)g.Bt + (size_t)nxt.pn * tstep : cB;
        for (int t = 0; t < nt; t += 2) {
            const bool last = (t == nt - 2);
            const char* a1 = cA + (size_t)(t + 1) * kstep;
            const char* a2 = last ? nA : cA + (size_t)(t + 2) * kstep; const char* b2 = last ? nB : cB + (size_t)(t + 2) * kstep;
            const char* a3 = a2 + kstep; const char* b3 = b2 + kstep;
            if (last && has_next) S.a_ready(nxt);
            if constexpr (SP2) {
            PG8_LDB(B0, 0, 0); PG8_LDB(B1, 0, 1); PG8_SCHED; PG8_LDA(At, 0, 0); PG8_STAGE(PG8_SA(1, 1), a1 + hstep, voffA);
            PG8_WAIT_V(8); PG8_WAIT_L(0); PG8_BAR; PG8_MMA(0, 0, At, B0); PG8_MMA(0, 1, At, B1); PG8_BAR; PG8_SCHED;
            PG8_LDA(At, 0, 1); PG8_STAGE(PG8_SB(0, 0), b2, voffB); PG8_STAGE(PG8_SB(0, 1), b2 + hstep, voffB); PG8_STAGE(PG8_SA(0, 0), a2, voffA);
            PG8_WAIT_V(8); PG8_WAIT_L(0); PG8_BAR; PG8_MMA(1, 0, At, B0); PG8_MMA(1, 1, At, B1); PG8_BAR; PG8_SCHED;
            PG8_LDB(B0, 1, 0); PG8_LDB(B1, 1, 1); PG8_SCHED; PG8_LDA(At, 1, 0); PG8_STAGE(PG8_SA(0, 1), a2 + hstep, voffA);
            PG8_WAIT_V(8); PG8_WAIT_L(0); PG8_BAR; PG8_MMA(0, 0, At, B0); PG8_MMA(0, 1, At, B1); PG8_BAR; PG8_SCHED;
            PG8_LDA(At, 1, 1); PG8_STAGE(PG8_SB(1, 0), b3, voffB); PG8_STAGE(PG8_SB(1, 1), b3 + hstep, voffB); PG8_STAGE(PG8_SA(1, 0), a3, voffA);
            PG8_WAIT_V(8); PG8_WAIT_L(0); PG8_BAR; PG8_MMA(1, 0, At, B0); PG8_MMA(1, 1, At, B1); PG8_BAR; PG8_SCHED;
            } else {
            PG8_LDB(B0, 0, 0); PG8_SCHED; PG8_LDA(At, 0, 0); PG8_STAGE(PG8_SA(1, 1), a1 + hstep, voffA);
            PG8_WAIT_L(8); PG8_BAR; PG8_WAIT_L(0); PG8_MMA(0, 0, At, B0); PG8_BAR; PG8_SCHED;
            PG8_LDB(B1, 0, 1); PG8_STAGE(PG8_SB(0, 0), b2, voffB);
            PG8_BAR; PG8_WAIT_L(0); PG8_MMA(0, 1, At, B1); PG8_BAR;
            PG8_LDA(At, 0, 1); PG8_STAGE(PG8_SA(0, 0), a2, voffA);
            PG8_BAR; PG8_WAIT_L(0); PG8_MMA(1, 0, At, B0); PG8_BAR; PG8_SCHED;
            PG8_STAGE(PG8_SB(0, 1), b2 + hstep, voffB);
            PG8_WAIT_V(6); PG8_BAR; PG8_MMA(1, 1, At, B1); PG8_BAR;
            PG8_LDB(B0, 1, 0); PG8_SCHED; PG8_LDA(At, 1, 0); PG8_STAGE(PG8_SA(0, 1), a2 + hstep, voffA);
            PG8_WAIT_L(8); PG8_BAR; PG8_WAIT_L(0); PG8_MMA(0, 0, At, B0); PG8_BAR; PG8_SCHED;
            PG8_LDB(B1, 1, 1); PG8_STAGE(PG8_SB(1, 0), b3, voffB);
            PG8_BAR; PG8_WAIT_L(0); PG8_MMA(0, 1, At, B1); PG8_BAR;
            PG8_LDA(At, 1, 1); PG8_STAGE(PG8_SA(1, 0), a3, voffA);
            PG8_BAR; PG8_WAIT_L(0); PG8_MMA(1, 0, At, B0); PG8_BAR; PG8_SCHED;
            PG8_STAGE(PG8_SB(1, 1), b3 + hstep, voffB);
            PG8_WAIT_V(6); PG8_BAR; PG8_MMA(1, 1, At, B1); PG8_BAR;
            }
        }
        if constexpr (ALIGN_EPI) { if (wr == 0) PG8_BAR; }
        if constexpr (!Epi::AFTER_DRAIN) { E(acc, cur, wr, wc, fr, fq); S.done(cur); }
        if (!has_next) break;
#pragma unroll
        for (int a = 0; a < 2; ++a)
#pragma unroll
            for (int b = 0; b < 2; ++b)
#pragma unroll
                for (int m = 0; m < 4; ++m)
#pragma unroll
                    for (int n = 0; n < 2; ++n) acc[a][b][m][n] = (f32x4){0.f, 0.f, 0.f, 0.f};
        cur = nxt; cA = nA; cB = nB; ++ui;
        if constexpr (ALIGN_EPI) { if (wr == 1) PG8_BAR; }
    }
    PG8_WAIT_V(0);
    if constexpr (!ALIGN_EPI) { if (wr == 0) PG8_BAR; }
    PG8_BAR;
    if constexpr (Epi::AFTER_DRAIN) { E.fused(acc, cur, wr, wc, fr, fq, lds, wid, lane); S.done(cur); }
#undef PG8_SA
#undef PG8_SB
#undef PG8_STAGE
#undef PG8_LDA
#undef PG8_LDB
#undef PG8_MMA
#undef PG8_WAIT_V
#undef PG8_WAIT_L
#undef PG8_BAR
#undef PG8_SCHED
}
}

#define LAS __attribute__((address_space(3)))
typedef unsigned short bf16_t;
typedef float f32x4 __attribute__((ext_vector_type(4)));
typedef unsigned u32x4 __attribute__((ext_vector_type(4)));
typedef unsigned u32x2 __attribute__((ext_vector_type(2)));
constexpr int SEQ = 8192, DM = 2048, DEPTH = 2, DFF = 8192;
constexpr int PROJ_W = 5136, PROJ_P = 5376;
constexpr int C_AQ = 0, C_AK = 768, C_AV = 1024, C_BQ = 1280, C_BK = 1664, C_BV = 2048, C_BR = 2816, C_CQ = 3584, C_CK = 4096, C_CV = 4608, C_LR = 5120;
constexpr float RMS_EPS = 1e-6f;
constexpr int NWAVES = 8, NTHREADS = 512;
constexpr int LDS_BYTES = 147456;

constexpr size_t MiB = 1u << 20;
constexpr size_t WS_CTL = 0;
constexpr size_t WS_ROWSS = 1 * MiB;
constexpr size_t WS_DECAY = 3 * MiB;
constexpr size_t WS_WT = 4 * MiB;
constexpr size_t WT_IN = 0, WT_OUT = 21 * MiB, WT_1 = 29 * MiB, WT_2 = 61 * MiB, WT_LAYER = 93 * MiB;
constexpr size_t WS_XB = 190 * MiB;
constexpr size_t WS_PROJ = 222 * MiB;
constexpr size_t WS_OA = 306 * MiB;
constexpr size_t WS_OC = 330 * MiB;
constexpr size_t WS_OB = 346 * MiB;
constexpr size_t WS_DSTATE = 370 * MiB;
constexpr size_t WS_SPREV = 406 * MiB;
constexpr size_t WS_QDEC = 424 * MiB;
constexpr size_t WS_MIXED = 430 * MiB;
constexpr size_t WS_HID = 222 * MiB;
constexpr size_t WS_END = 462 * MiB;

__device__ const unsigned char T5B[128] = {0, 1, 2, 3, 4, 5, 6, 7, 8, 9, 10, 11, 12, 13, 14, 15, 16, 16, 16, 17, 17, 18, 18, 18, 19, 19, 19, 20, 20, 20, 20, 21, 21, 21, 21, 22, 22, 22, 22, 22, 23, 23, 23, 23, 23, 23, 24, 24, 24, 24, 24, 24, 25, 25, 25, 25, 25, 25, 25, 26, 26, 26, 26, 26, 26, 26, 26, 27, 27, 27, 27, 27, 27, 27, 27, 27, 27, 28, 28, 28, 28, 28, 28, 28, 28, 28, 28, 29, 29, 29, 29, 29, 29, 29, 29, 29, 29, 29, 29, 30, 30, 30, 30, 30, 30, 30, 30, 30, 30, 30, 30, 30, 30, 31, 31, 31, 31, 31, 31, 31, 31, 31, 31, 31, 31, 31, 31, 31};

__device__ __forceinline__ float bf2f(bf16_t u) { return __uint_as_float((unsigned)u << 16); }
__device__ __forceinline__ float bflo(unsigned x) { return __uint_as_float(x << 16); }
__device__ __forceinline__ float bfhi(unsigned x) { return __uint_as_float(x & 0xffff0000u); }
__device__ __forceinline__ unsigned f2bf(float f) { unsigned u = __float_as_uint(f); return (u + 0x7fffu + ((u >> 16) & 1u)) >> 16; }
__device__ __forceinline__ unsigned pk2(float lo, float hi) { return f2bf(lo) | (f2bf(hi) << 16); }
__device__ __forceinline__ float wave_sum(float v) {
#pragma unroll
    for (int o = 1; o < 64; o <<= 1) v += __shfl_xor(v, o);
    return v;
}
__device__ __forceinline__ float wave_max(float v) {
#pragma unroll
    for (int o = 1; o < 64; o <<= 1) v = fmaxf(v, __shfl_xor(v, o));
    return v;
}
__device__ __forceinline__ float wave_incl_scan(float x, int lane) {
#pragma unroll
    for (int o = 1; o < 64; o <<= 1) { const float y = __shfl_up(x, o); if (lane >= o) x += y; }
    return x;
}
__device__ __forceinline__ float softplusf(float z) { return fmaxf(z, 0.f) + log1pf(__expf(-fabsf(z))); }
#define LDS_WAIT() asm volatile("s_waitcnt lgkmcnt(0)" ::: "memory")

namespace pg8 {
template <int ACT> struct EpiScale {
    static constexpr bool PERM = true, AFTER_DRAIN = false;
    bf16_t* O; int ldc; const float* rowss;
    __device__ __forceinline__ void operator()(const f32x4 (&acc)[2][2][4][2], const Unit& u, int wr, int wc, int fr, int fq) const {
        const int row0 = u.pm * BM + wr * 64 + fr, col0 = u.pn * BM + wc * 32 + 8 * fq;
#pragma unroll
        for (int ai = 0; ai < 2; ++ai)
#pragma unroll
            for (int m = 0; m < 4; ++m) {
                const int row = row0 + ai * HALF + m * 16;
                const f32x4* pp = (const f32x4*)(rowss + (size_t)row * 32 + fq * 8);
                const f32x4 pa = pp[0], pb = pp[1];
                float s = ((pa[0] + pa[1]) + (pa[2] + pa[3])) + ((pb[0] + pb[1]) + (pb[2] + pb[3]));
                s += __shfl_xor(s, 16); s += __shfl_xor(s, 32);
                const float rstd = rsqrtf(s * (1.0f / 2048.0f) + 1e-6f);
                bf16_t* rowp = O + (size_t)row * ldc + col0;
#pragma unroll
                for (int bj = 0; bj < 2; ++bj) {
                    f32x4 v0 = acc[ai][bj][m][0] * rstd, v1 = acc[ai][bj][m][1] * rstd;
                    if (ACT == 1) {
#pragma unroll
                        for (int e = 0; e < 4; ++e) { const float a = fmaxf(v0[e], 0.f), b = fmaxf(v1[e], 0.f); v0[e] = a * a; v1[e] = b * b; }
                    }
                    u32x4 w; w.x = cvt_pk_bf16(v0[0], v0[1]); w.y = cvt_pk_bf16(v0[2], v0[3]); w.z = cvt_pk_bf16(v1[0], v1[1]); w.w = cvt_pk_bf16(v1[2], v1[3]);
                    *(u32x4*)(rowp + bj * HALF) = w;
                }
            }
    }
};
struct EpiResid {
    static constexpr bool PERM = true, AFTER_DRAIN = false;
    const float* base; float* out; bf16_t* xb; float* rowss;
    __device__ __forceinline__ void operator()(const f32x4 (&acc)[2][2][4][2], const Unit& u, int wr, int wc, int fr, int fq) const {
        const int row0 = u.pm * BM + wr * 64 + fr, col0 = u.pn * BM + wc * 32 + 8 * fq;
#pragma unroll
        for (int ai = 0; ai < 2; ++ai)
#pragma unroll
            for (int m = 0; m < 4; ++m) {
                const int row = row0 + ai * HALF + m * 16;
                const size_t off = (size_t)row * 2048 + col0;
                float ss = 0.f;
#pragma unroll
                for (int bj = 0; bj < 2; ++bj) {
                    f32x4 o0 = *(const f32x4*)(base + off + bj * HALF), o1 = *(const f32x4*)(base + off + bj * HALF + 4);
                    o0 += acc[ai][bj][m][0]; o1 += acc[ai][bj][m][1];
                    *(f32x4*)(out + off + bj * HALF) = o0; *(f32x4*)(out + off + bj * HALF + 4) = o1;
                    ss += ((o0[0] * o0[0] + o0[1] * o0[1]) + (o0[2] * o0[2] + o0[3] * o0[3])) + ((o1[0] * o1[0] + o1[1] * o1[1]) + (o1[2] * o1[2] + o1[3] * o1[3]));
                    u32x4 w; w.x = cvt_pk_bf16(o0[0], o0[1]); w.y = cvt_pk_bf16(o0[2], o0[3]); w.z = cvt_pk_bf16(o1[0], o1[1]); w.w = cvt_pk_bf16(o1[2], o1[3]);
                    *(u32x4*)(xb + off + bj * HALF) = w;
                }
                ss += __shfl_xor(ss, 16); ss += __shfl_xor(ss, 32);
                if (fq == 0) rowss[(size_t)row * 32 + u.pn * 4 + wc] = ss;
                if (m & 1) asm volatile("" ::: "memory");
            }
    }
};
}

__device__ __forceinline__ void p0_transpose_item(const float* __restrict__ W, int K, int N, const float* __restrict__ gain, bf16_t* __restrict__ WT, int kind, LAS float* scr, int item, int lane) {
    const int nblk = (kind == 1) ? (PROJ_P / 64) : (N / 64);
    const int kb = item / nblk, nb = item % nblk, k0 = 64 * kb, n0 = 64 * nb;
    int src0 = n0, nvalid = 64;
    if (kind == 1) { if (n0 < 3584) { src0 = n0; } else if (n0 < 5120) { src0 = n0 + 16; } else if (n0 == 5120) { src0 = 3584; nvalid = 16; } else { src0 = 0; nvalid = 0; } }
    const int c4 = (lane & 15) * 4;
#pragma unroll 4
    for (int i = 0; i < 16; ++i) {
        const int kk = 4 * i + (lane >> 4);
        f32x4 v = (f32x4){0.f, 0.f, 0.f, 0.f};
        if (c4 < nvalid) v = *(const f32x4*)(W + (size_t)(k0 + kk) * N + src0 + c4);
        const float g = gain ? gain[k0 + kk] : 1.0f;
        LAS float* d = scr + kk * 65 + c4;
        d[0] = v[0] * g; d[1] = v[1] * g; d[2] = v[2] * g; d[3] = v[3] * g;
    }
    LDS_WAIT();
    const int c = lane & 7;
#pragma unroll
    for (int j = 0; j < 8; ++j) {
        const int n = 8 * j + (lane >> 3);
        const LAS float* s = scr + (8 * c) * 65 + n;
        u32x4 o; o.x = pk2(s[0 * 65], s[1 * 65]); o.y = pk2(s[2 * 65], s[3 * 65]); o.z = pk2(s[4 * 65], s[5 * 65]); o.w = pk2(s[6 * 65], s[7 * 65]);
        *(u32x4*)(WT + (size_t)(n0 + n) * K + k0 + 8 * c) = o;
    }
    LDS_WAIT();
}

__device__ __forceinline__ void swa_naive_item(const bf16_t* __restrict__ proj, const float* __restrict__ sinks, const float* __restrict__ relb, float* __restrict__ Oa, int t, int hq, LAS float* qs, int lane) {
    const int hk = hq / 3;
    LDS_WAIT();
    qs[lane] = bf2f(proj[(size_t)t * PROJ_P + C_AQ + hq * 64 + lane]);
    LDS_WAIT();
    float logit[2];
#pragma unroll
    for (int e = 0; e < 2; ++e) {
        const int dist = lane + 64 * e, s = t - dist;
        float acc = 0.f;
        if (s >= 0) {
            const u32x4* kr = (const u32x4*)(proj + (size_t)s * PROJ_P + C_AK + hk * 64);
#pragma unroll
            for (int c = 0; c < 8; ++c) {
                const u32x4 kv = kr[c];
                const f32x4 a = *(const LAS f32x4*)(qs + 8 * c), b = *(const LAS f32x4*)(qs + 8 * c + 4);
                acc += bflo(kv.x) * a[0] + bfhi(kv.x) * a[1] + bflo(kv.y) * a[2] + bfhi(kv.y) * a[3] + bflo(kv.z) * b[0] + bfhi(kv.z) * b[1] + bflo(kv.w) * b[2] + bfhi(kv.w) * b[3];
            }
            logit[e] = acc * 0.125f + relb[(int)T5B[dist] * 12 + hq];
        } else logit[e] = -1e30f;
    }
    const float sink = sinks[hq];
    float m = wave_max(fmaxf(logit[0], logit[1])); m = fmaxf(m, sink);
    const float e0 = (t - lane >= 0) ? __expf(logit[0] - m) : 0.f, e1 = (t - lane - 64 >= 0) ? __expf(logit[1] - m) : 0.f;
    const float den = wave_sum(e0 + e1) + __expf(sink - m);
    const float p0 = e0 / den, p1 = e1 / den;
    float o = 0.f;
    const bf16_t* vcol = proj + C_AV + hk * 64 + lane;
    for (int i = 0; i < 64; ++i) { const float pi = __shfl(p0, i); const int s = t - i; if (s >= 0) o += pi * bf2f(vcol[(size_t)s * PROJ_P]); }
    for (int i = 0; i < 64; ++i) { const float pi = __shfl(p1, i); const int s = t - 64 - i; if (s >= 0) o += pi * bf2f(vcol[(size_t)s * PROJ_P]); }
    Oa[(size_t)t * 768 + hq * 64 + lane] = o;
}
__device__ __forceinline__ void sb_naive_item(const bf16_t* __restrict__ proj, float* __restrict__ Oc, int t, int h, LAS float* qs, int lane) {
    LDS_WAIT();
    qs[lane] = bf2f(proj[(size_t)t * PROJ_P + C_CQ + h * 64 + lane]);
    LDS_WAIT();
    float R = 0.f, o = 0.f;
    const bf16_t* vcol = proj + C_CV + h * 64 + lane;
    for (int s_hi = t - 1; s_hi >= 0; s_hi -= 64) {
        const int s = s_hi - lane;
        float z = 0.f, L = 0.f;
        if (s >= 0) {
            const u32x4* kr = (const u32x4*)(proj + (size_t)s * PROJ_P + C_CK + h * 64);
            float acc = 0.f;
#pragma unroll
            for (int c = 0; c < 8; ++c) {
                const u32x4 kv = kr[c];
                const f32x4 a = *(const LAS f32x4*)(qs + 8 * c), b = *(const LAS f32x4*)(qs + 8 * c + 4);
                acc += bflo(kv.x) * a[0] + bfhi(kv.x) * a[1] + bflo(kv.y) * a[2] + bfhi(kv.y) * a[3] + bflo(kv.z) * b[0] + bfhi(kv.z) * b[1] + bflo(kv.w) * b[2] + bfhi(kv.w) * b[3];
            }
            z = acc * 0.125f; L = -softplusf(z);
        }
        const float C = R + wave_incl_scan(L, lane);
        const float w = (s >= 0) ? __expf(z + C) : 0.f;
        R = __shfl(C, 63);
        const int nk = (s_hi + 1 < 64) ? (s_hi + 1) : 64;
        for (int i = 0; i < nk; ++i) { const float wi = __shfl(w, i); o += wi * bf2f(vcol[(size_t)(s_hi - i) * PROJ_P]); }
        if (R < -105.0f) break;
    }
    Oc[(size_t)t * 512 + h * 64 + lane] = o;
}
__device__ __forceinline__ void gla_seq_item(const bf16_t* __restrict__ proj, const float* __restrict__ lgate, float* __restrict__ Ob, int h, int j, int lane) {
    float s0 = 0.f, s1 = 0.f;
    const bool two = lane < 32;
    const int kA = h * 96 + lane, kB = h * 96 + 64 + (lane & 31);
    for (int t0 = 0; t0 < SEQ; t0 += 8) {
        float g0[8], k0[8], q0[8], g1[8], k1[8], q1[8], vv[8];
#pragma unroll
        for (int u = 0; u < 8; ++u) {
            const bf16_t* row = proj + (size_t)(t0 + u) * PROJ_P; const float* lg = lgate + (size_t)(t0 + u) * 384;
            g0[u] = lg[kA]; k0[u] = bf2f(row[C_BK + kA]); q0[u] = bf2f(row[C_BQ + kA]);
            g1[u] = lg[kB]; k1[u] = bf2f(row[C_BK + kB]); q1[u] = bf2f(row[C_BQ + kB]);
            vv[u] = bf2f(row[C_BV + h * 192 + j]);
        }
#pragma unroll
        for (int u = 0; u < 8; ++u) {
            s0 = __expf(g0[u]) * s0 + k0[u] * vv[u];
            s1 = __expf(g1[u]) * s1 + k1[u] * vv[u];
            float a = q0[u] * s0 + (two ? q1[u] * s1 : 0.f);
            a = wave_sum(a);
            if (lane == 0) Ob[(size_t)(t0 + u) * 768 + h * 192 + j] = a * 0.10206207261596577f;
        }
    }
}
__device__ __forceinline__ void norm_mixed_row(const float* __restrict__ Oa, const float* __restrict__ Ob, const float* __restrict__ Oc, const bf16_t* __restrict__ proj,
                                               const float* __restrict__ gA, const float* __restrict__ gB, const float* __restrict__ gC, bf16_t* __restrict__ mixed, int t, int lane) {
    bf16_t* mrow = mixed + (size_t)t * 2048;
    {
        float a[12], ss = 0.f;
#pragma unroll
        for (int i = 0; i < 12; ++i) { a[i] = Oa[(size_t)t * 768 + lane + 64 * i]; ss += a[i] * a[i]; }
        const float r = rsqrtf(wave_sum(ss) * (1.0f / 768.0f) + RMS_EPS);
#pragma unroll
        for (int i = 0; i < 12; ++i) mrow[lane + 64 * i] = (bf16_t)f2bf(a[i] * r * gA[lane + 64 * i]);
    }
#pragma unroll
    for (int h = 0; h < 4; ++h) {
        float b[3], ss = 0.f;
#pragma unroll
        for (int i = 0; i < 3; ++i) { b[i] = Ob[(size_t)t * 768 + h * 192 + lane + 64 * i]; ss += b[i] * b[i]; }
        const float r = rsqrtf(wave_sum(ss) * (1.0f / 192.0f) + RMS_EPS);
#pragma unroll
        for (int i = 0; i < 3; ++i) {
            const int c = lane + 64 * i;
            const float br = bf2f(proj[(size_t)t * PROJ_P + C_BR + h * 192 + c]);
            const float y = b[i] * r * gB[c] * (br / (1.0f + __expf(-br)));
            mrow[768 + h * 192 + c] = (bf16_t)f2bf(y);
        }
    }
    {
        float a[8], ss = 0.f;
#pragma unroll
        for (int i = 0; i < 8; ++i) { a[i] = Oc[(size_t)t * 512 + lane + 64 * i]; ss += a[i] * a[i]; }
        const float r = rsqrtf(wave_sum(ss) * (1.0f / 512.0f) + RMS_EPS);
#pragma unroll
        for (int i = 0; i < 8; ++i) mrow[1536 + lane + 64 * i] = (bf16_t)f2bf(a[i] * r * gC[lane + 64 * i]);
    }
}


typedef short bf16x8 __attribute__((ext_vector_type(8)));
typedef short s16x4 __attribute__((ext_vector_type(4)));
__device__ __forceinline__ f32x4 mfma16(bf16x8 a, bf16x8 b, f32x4 c) { return __builtin_amdgcn_mfma_f32_16x16x32_bf16(a, b, c, 0, 0, 0); }
__device__ __forceinline__ bf16x8 lds_frag_row(const LAS unsigned char* base, int stride, int r0, int k0, int lane) {
    return *(const LAS bf16x8*)(base + (r0 + (lane & 15)) * stride + (k0 + 8 * (lane >> 4)) * 2);
}
__device__ __forceinline__ bf16x8 lds_frag_tr(const LAS unsigned char* base, int stride, int k0, int c0, int lane) {
    const int g = lane >> 4, i = lane & 15;
    const LAS unsigned char* p = base + (k0 + 8 * g + (i >> 2)) * stride + (c0 + 4 * (i & 3)) * 2;
    const s16x4 lo = __builtin_bit_cast(s16x4, __builtin_amdgcn_ds_read_tr16_b64_v4i16((LAS s16x4*)p));
    const s16x4 hi = __builtin_bit_cast(s16x4, __builtin_amdgcn_ds_read_tr16_b64_v4i16((LAS s16x4*)(p + 4 * stride)));
    return (bf16x8){lo[0], lo[1], lo[2], lo[3], hi[0], hi[1], hi[2], hi[3]};
}

constexpr int GL_LG = 0, GL_QD = 24832, GL_KI = 38144, GL_KE = 51456, GL_VS = 64768, GL_SC = 90368, GL_BLR = 99584, GL_GW = 103680, GL_BL = 109824;
__device__ __forceinline__ void gla_local_item(LAS unsigned char* lds, const bf16_t* __restrict__ proj, const float* __restrict__ gwt  , const float* __restrict__ gbs  ,
                                               float* __restrict__ Ob, float* __restrict__ dstate, float* __restrict__ decay, bf16_t* __restrict__ qdec, int n, int h, int tid) {
    const int lane = tid & 63, wave = __builtin_amdgcn_readfirstlane(tid >> 6), g4 = lane >> 4, l15 = lane & 15;
    const int t0 = 64 * n;
    LAS float* lg = (LAS float*)(lds + GL_LG); LAS float* blr = (LAS float*)(lds + GL_BLR); LAS float* gw = (LAS float*)(lds + GL_GW); LAS float* bl = (LAS float*)(lds + GL_BL);
    if (tid < 128) {
        const int row = tid >> 1, half = tid & 1;
        const u32x4 v = *(const u32x4*)(proj + (size_t)(t0 + row) * PROJ_P + C_LR + 8 * half);
        LAS float* d = blr + row * 16 + 8 * half;
        d[0] = bflo(v.x); d[1] = bfhi(v.x); d[2] = bflo(v.y); d[3] = bfhi(v.y); d[4] = bflo(v.z); d[5] = bfhi(v.z); d[6] = bflo(v.w); d[7] = bfhi(v.w);
    }
    for (int i = tid; i < 16 * 96; i += NTHREADS) { const int r = i / 96, c = i % 96; gw[i] = gwt[r * 384 + h * 96 + c]; }
#pragma unroll
    for (int i = 0; i < 3; ++i) {
        const int id = tid + NTHREADS * i, row = id / 24, ch = id % 24;
        const u32x4 v = *(const u32x4*)(proj + (size_t)(t0 + row) * PROJ_P + C_BV + h * 192 + 8 * ch);
        *(LAS u32x4*)(lds + GL_VS + row * 400 + ch * 16) = v;
    }
    __syncthreads();
    for (int i = tid; i < 64 * 96; i += NTHREADS) {
        const int t = i / 96, k = i % 96;
        float gp = gbs[h * 96 + k];
#pragma unroll
        for (int r = 0; r < 16; ++r) gp += blr[t * 16 + r] * gw[r * 96 + k];
        const float ls = fminf(gp, 0.f) - log1pf(__expf(-fabsf(gp)));
        lg[t * 97 + k] = fmaxf(ls * (1.0f / 16.0f), -1.0f);
    }
    __syncthreads();
    if (tid < 384) {
        const int k = tid >> 2, part = tid & 3;
        float run = 0.f;
#pragma unroll
        for (int i = 0; i < 16; ++i) { run += lg[(16 * part + i) * 97 + k]; lg[(16 * part + i) * 97 + k] = run; }
        const float o1 = __shfl_up(run, 1), o2 = __shfl_up(run, 2), o3 = __shfl_up(run, 3);
        const float off = (part >= 1 ? o1 : 0.f) + (part >= 2 ? o2 : 0.f) + (part >= 3 ? o3 : 0.f);
#pragma unroll
        for (int i = 0; i < 16; ++i) lg[(16 * part + i) * 97 + k] += off;
        if (part == 3) bl[k] = run + off;
    }
    __syncthreads();
    for (int i = tid; i < 64 * 96; i += NTHREADS) {
        const int t = i / 96, k = i % 96;
        const float b = lg[t * 97 + k];
        const bf16_t* row = proj + (size_t)(t0 + t) * PROJ_P;
        const float q = bf2f(row[C_BQ + h * 96 + k]), kk = bf2f(row[C_BK + h * 96 + k]);
        const unsigned qd = f2bf(q * 0.10206207261596577f * __expf(b)), ki = f2bf(kk * __expf(-b)), ke = f2bf(kk * __expf(bl[k] - b));
        *(LAS bf16_t*)(lds + GL_QD + t * 208 + k * 2) = (bf16_t)qd;
        *(LAS bf16_t*)(lds + GL_KI + t * 208 + k * 2) = (bf16_t)ki;
        *(LAS bf16_t*)(lds + GL_KE + t * 208 + k * 2) = (bf16_t)ke;
        qdec[(size_t)(t0 + t) * 384 + h * 96 + k] = (bf16_t)qd;
    }
    if (tid < 96) decay[(n * 4 + h) * 96 + tid] = __expf(bl[tid]);
    __syncthreads();
    {
        const int rt = wave >> 1;
        f32x4 acc[2] = {(f32x4){0.f, 0.f, 0.f, 0.f}, (f32x4){0.f, 0.f, 0.f, 0.f}};
#pragma unroll
        for (int ks = 0; ks < 3; ++ks) {
            const bf16x8 a = lds_frag_row(lds + GL_QD, 208, 16 * rt, 32 * ks, lane);
#pragma unroll
            for (int c = 0; c < 2; ++c) { const bf16x8 b = lds_frag_row(lds + GL_KI, 208, 16 * (2 * (wave & 1) + c), 32 * ks, lane); acc[c] = mfma16(a, b, acc[c]); }
        }
#pragma unroll
        for (int c = 0; c < 2; ++c) {
            const int s = 16 * (2 * (wave & 1) + c) + l15;
#pragma unroll
            for (int i = 0; i < 4; ++i) { const int t = 16 * rt + 4 * g4 + i; *(LAS bf16_t*)(lds + GL_SC + t * 144 + s * 2) = (bf16_t)f2bf(s <= t ? acc[c][i] : 0.f); }
        }
    }
    __syncthreads();
    {
        const int rt = wave >> 1;
        const bf16x8 a0 = lds_frag_row(lds + GL_SC, 144, 16 * rt, 0, lane), a1 = lds_frag_row(lds + GL_SC, 144, 16 * rt, 32, lane);
#pragma unroll
        for (int c = 0; c < 6; ++c) {
            const int ct = 6 * (wave & 1) + c;
            const bf16x8 b0 = lds_frag_tr(lds + GL_VS, 400, 0, 16 * ct, lane), b1 = lds_frag_tr(lds + GL_VS, 400, 32, 16 * ct, lane);
            f32x4 acc = mfma16(a0, b0, (f32x4){0.f, 0.f, 0.f, 0.f}); acc = mfma16(a1, b1, acc);
#pragma unroll
            for (int i = 0; i < 4; ++i) Ob[(size_t)(t0 + 16 * rt + 4 * g4 + i) * 768 + h * 192 + 16 * ct + l15] = acc[i];
        }
#pragma unroll
        for (int c = 0; c < 9; ++c) {
            const int T = wave * 9 + c, kt = T / 12, ct = T % 12;
            const bf16x8 a0 = lds_frag_tr(lds + GL_KE, 208, 0, 16 * kt, lane), a1 = lds_frag_tr(lds + GL_KE, 208, 32, 16 * kt, lane);
            const bf16x8 b0 = lds_frag_tr(lds + GL_VS, 400, 0, 16 * ct, lane), b1 = lds_frag_tr(lds + GL_VS, 400, 32, 16 * ct, lane);
            f32x4 acc = mfma16(a0, b0, (f32x4){0.f, 0.f, 0.f, 0.f}); acc = mfma16(a1, b1, acc);
            *(f32x4*)(dstate + ((size_t)(n * 4 + h) * 192 + 16 * ct + l15) * 96 + 16 * kt + 4 * g4) = acc;
        }
    }
    __syncthreads();
}
__device__ __forceinline__ void gla_scan_elem(const float* __restrict__ dstate, const float* __restrict__ decay, bf16_t* __restrict__ sprev, int e) {
    const int h = e / 18432, dk = e % 96;
    float S = 0.f;
    for (int n0 = 0; n0 < 128; n0 += 8) {
        float ds[8], dc[8];
#pragma unroll
        for (int u = 0; u < 8; ++u) { ds[u] = dstate[(size_t)(n0 + u) * 73728 + e]; dc[u] = decay[((n0 + u) * 4 + h) * 96 + dk]; }
#pragma unroll
        for (int u = 0; u < 8; ++u) { sprev[(size_t)(n0 + u) * 73728 + e] = (bf16_t)f2bf(S); S = dc[u] * S + ds[u]; }
    }
}
__device__ __forceinline__ void gla_out_item(LAS unsigned char* lds, const bf16_t* __restrict__ proj, const bf16_t* __restrict__ qdec, const bf16_t* __restrict__ sprev, const float* __restrict__ Ob,
                                             const float* __restrict__ gB, bf16_t* __restrict__ mixed, int n, int h, int tid) {
    const int lane = tid & 63, wave = __builtin_amdgcn_readfirstlane(tid >> 6), g4 = lane >> 4, l15 = lane & 15;
    const int t0 = 64 * n, rt = wave >> 1;
    LAS float* ssx = (LAS float*)lds;
    bf16x8 a[3];
#pragma unroll
    for (int ks = 0; ks < 3; ++ks) a[ks] = *(const bf16x8*)(qdec + (size_t)(t0 + 16 * rt + l15) * 384 + h * 96 + 32 * ks + 8 * g4);
    f32x4 o[6]; float ss[4] = {0.f, 0.f, 0.f, 0.f};
#pragma unroll
    for (int c = 0; c < 6; ++c) {
        const int dv = 16 * (6 * (wave & 1) + c) + l15;
        const bf16_t* sp = sprev + ((size_t)(n * 4 + h) * 192 + dv) * 96 + 8 * g4;
        f32x4 acc = (f32x4){0.f, 0.f, 0.f, 0.f};
#pragma unroll
        for (int ks = 0; ks < 3; ++ks) acc = mfma16(a[ks], *(const bf16x8*)(sp + 32 * ks), acc);
#pragma unroll
        for (int i = 0; i < 4; ++i) { acc[i] += Ob[(size_t)(t0 + 16 * rt + 4 * g4 + i) * 768 + h * 192 + dv]; ss[i] += acc[i] * acc[i]; }
        o[c] = acc;
    }
#pragma unroll
    for (int i = 0; i < 4; ++i) {
        float s = ss[i];
        s += __shfl_xor(s, 1); s += __shfl_xor(s, 2); s += __shfl_xor(s, 4); s += __shfl_xor(s, 8);
        if (l15 == 0) ssx[(16 * rt + 4 * g4 + i) * 2 + (wave & 1)] = s;
    }
    __syncthreads();
    float r[4];
#pragma unroll
    for (int i = 0; i < 4; ++i) { const int row = 16 * rt + 4 * g4 + i; r[i] = rsqrtf((ssx[row * 2] + ssx[row * 2 + 1]) * (1.0f / 192.0f) + RMS_EPS); }
#pragma unroll
    for (int c = 0; c < 6; ++c) {
        const int dv = 16 * (6 * (wave & 1) + c) + l15;
        const float gn = gB[dv];
#pragma unroll
        for (int i = 0; i < 4; ++i) {
            const int t = t0 + 16 * rt + 4 * g4 + i;
            const float br = bf2f(proj[(size_t)t * PROJ_P + C_BR + h * 192 + dv]);
            mixed[(size_t)t * 2048 + 768 + h * 192 + dv] = (bf16_t)f2bf(o[c][i] * r[i] * gn * (br / (1.0f + __expf(-br))));
        }
    }
    __syncthreads();
}
__device__ __forceinline__ void norm_ac_row(const float* __restrict__ Oa, const float* __restrict__ Oc, const float* __restrict__ gA, const float* __restrict__ gC, bf16_t* __restrict__ mixed, int t, int lane) {
    bf16_t* mrow = mixed + (size_t)t * 2048;
    {
        float a[12], ss = 0.f;
#pragma unroll
        for (int i = 0; i < 12; ++i) { a[i] = Oa[(size_t)t * 768 + lane + 64 * i]; ss += a[i] * a[i]; }
        const float r = rsqrtf(wave_sum(ss) * (1.0f / 768.0f) + RMS_EPS);
#pragma unroll
        for (int i = 0; i < 12; ++i) mrow[lane + 64 * i] = (bf16_t)f2bf(a[i] * r * gA[lane + 64 * i]);
    }
    {
        float a[8], ss = 0.f;
#pragma unroll
        for (int i = 0; i < 8; ++i) { a[i] = Oc[(size_t)t * 512 + lane + 64 * i]; ss += a[i] * a[i]; }
        const float r = rsqrtf(wave_sum(ss) * (1.0f / 512.0f) + RMS_EPS);
#pragma unroll
        for (int i = 0; i < 8; ++i) mrow[1536 + lane + 64 * i] = (bf16_t)f2bf(a[i] * r * gC[lane + 64 * i]);
    }
}


constexpr int SB_QS = 0, SB_KS = 18432, SB_VS = 27648, SB_ZS = 36864, SB_PS = 70144, SB_FL = 88576;
__device__ __forceinline__ void sb_item(LAS unsigned char* lds, const bf16_t* __restrict__ proj, float* __restrict__ Oc, int h, int qb, int tid) {
    const int lane = tid & 63, wave = __builtin_amdgcn_readfirstlane(tid >> 6), g4 = lane >> 4, l15 = lane & 15;
    const int q0 = 128 * qb;
#pragma unroll
    for (int i = 0; i < 2; ++i) {
        const int id = tid + NTHREADS * i, row = id >> 3, ch = id & 7;
        *(LAS u32x4*)(lds + SB_QS + row * 144 + ch * 16) = *(const u32x4*)(proj + (size_t)(q0 + row) * PROJ_P + C_CQ + h * 64 + 8 * ch);
    }
    f32x4 oacc[4];
#pragma unroll
    for (int d = 0; d < 4; ++d) oacc[d] = (f32x4){0.f, 0.f, 0.f, 0.f};
    float R = 0.f;
    const int r = tid >> 2, c4 = tid & 3, t = q0 + r;
    LAS float* Zs = (LAS float*)(lds + SB_ZS);
    LAS int* FL = (LAS int*)(lds + SB_FL);
    for (int kt = 2 * qb + 1; kt >= 0; --kt) {
        const int s0 = 64 * kt;
        {
            const int row = tid >> 3, ch = tid & 7;
            const bf16_t* src = proj + (size_t)(s0 + row) * PROJ_P + h * 64 + 8 * ch;
            *(LAS u32x4*)(lds + SB_KS + row * 144 + ch * 16) = *(const u32x4*)(src + C_CK);
            *(LAS u32x4*)(lds + SB_VS + row * 144 + ch * 16) = *(const u32x4*)(src + C_CV);
        }
        __syncthreads();
        {
            const bf16x8 a0 = lds_frag_row(lds + SB_QS, 144, 16 * wave, 0, lane), a1 = lds_frag_row(lds + SB_QS, 144, 16 * wave, 32, lane);
#pragma unroll
            for (int ct = 0; ct < 4; ++ct) {
                const bf16x8 b0 = lds_frag_row(lds + SB_KS, 144, 16 * ct, 0, lane), b1 = lds_frag_row(lds + SB_KS, 144, 16 * ct, 32, lane);
                f32x4 acc = mfma16(a0, b0, (f32x4){0.f, 0.f, 0.f, 0.f}); acc = mfma16(a1, b1, acc);
#pragma unroll
                for (int i = 0; i < 4; ++i) Zs[(16 * wave + 4 * g4 + i) * 65 + 16 * ct + l15] = acc[i] * 0.125f;
            }
        }
        __syncthreads();
        {
            float z[16], C[16], run = 0.f;
#pragma unroll
            for (int e = 15; e >= 0; --e) {
                const int s = s0 + 16 * c4 + e;
                z[e] = Zs[r * 65 + 16 * c4 + e];
                const float L = (s < t) ? -softplusf(z[e]) : 0.f;
                run += L; C[e] = run;
            }
            const float a1 = __shfl_down(run, 1), a2 = __shfl_down(run, 2), a3 = __shfl_down(run, 3);
            const float off = R + (c4 <= 2 ? a1 : 0.f) + (c4 <= 1 ? a2 : 0.f) + (c4 <= 0 ? a3 : 0.f);
            unsigned pw[8];
#pragma unroll
            for (int e = 0; e < 16; e += 2) {
                const int s = s0 + 16 * c4 + e;
                const float w0 = (s < t) ? __expf(z[e] + C[e] + off) : 0.f, w1 = (s + 1 < t) ? __expf(z[e + 1] + C[e + 1] + off) : 0.f;
                pw[e >> 1] = pk2(w0, w1);
            }
            LAS u32x4* pd = (LAS u32x4*)(lds + SB_PS + r * 144 + c4 * 32);
            pd[0] = (u32x4){pw[0], pw[1], pw[2], pw[3]}; pd[1] = (u32x4){pw[4], pw[5], pw[6], pw[7]};
            float tt = run + __shfl_xor(run, 1); tt += __shfl_xor(tt, 2);
            R += tt;
            const int alld = __all(R < -105.0f);
            if (lane == 0) FL[wave] = alld;
        }
        __syncthreads();
        bool done = true;
        {
            const bf16x8 a0 = lds_frag_row(lds + SB_PS, 144, 16 * wave, 0, lane), a1 = lds_frag_row(lds + SB_PS, 144, 16 * wave, 32, lane);
#pragma unroll
            for (int d = 0; d < 4; ++d) {
                const bf16x8 b0 = lds_frag_tr(lds + SB_VS, 144, 0, 16 * d, lane), b1 = lds_frag_tr(lds + SB_VS, 144, 32, 16 * d, lane);
                oacc[d] = mfma16(a0, b0, oacc[d]); oacc[d] = mfma16(a1, b1, oacc[d]);
            }
#pragma unroll
            for (int w = 0; w < 8; ++w) done = done && (FL[w] != 0);
        }
        __syncthreads();
        if (done) break;
    }
#pragma unroll
    for (int d = 0; d < 4; ++d)
#pragma unroll
        for (int i = 0; i < 4; ++i) Oc[(size_t)(q0 + 16 * wave + 4 * g4 + i) * 512 + h * 64 + 16 * d + l15] = oacc[d][i];
}

constexpr int SW_KS = 0, SW_VS = 36864, SW_PS = 76032, SW_PSW = 5376, SW_BT = 119040;
__device__ __forceinline__ void swa_item(LAS unsigned char* lds, const bf16_t* __restrict__ proj, const float* __restrict__ sinks, const float* __restrict__ relb, float* __restrict__ Oa, int n, int hk, int tid) {
    const int lane = tid & 63, wave = __builtin_amdgcn_readfirstlane(tid >> 6), g4 = lane >> 4, l15 = lane & 15;
#pragma unroll
    for (int i = 0; i < 4; ++i) {
        const int id = tid + NTHREADS * i, row = id >> 3, ch = id & 7, s = 128 * (n - 1) + row;
        u32x4 kv = (u32x4){0u, 0u, 0u, 0u}, vv = (u32x4){0u, 0u, 0u, 0u};
        if (s >= 0) { const bf16_t* src = proj + (size_t)s * PROJ_P + hk * 64 + 8 * ch; kv = *(const u32x4*)(src + C_AK); vv = *(const u32x4*)(src + C_AV); }
        *(LAS u32x4*)(lds + SW_KS + row * 144 + ch * 16) = kv;
        *(LAS u32x4*)(lds + SW_VS + row * 144 + ch * 16) = vv;
    }
    if (tid < 128) { const int row = 256 + (tid >> 3), ch = tid & 7; *(LAS u32x4*)(lds + SW_VS + row * 144 + ch * 16) = (u32x4){0u, 0u, 0u, 0u}; }
    if (tid < 384) { const int g = tid >> 7, dist = tid & 127; ((LAS float*)(lds + SW_BT))[tid] = relb[(int)T5B[dist] * 12 + 3 * hk + g]; }
    LAS unsigned char* Pw = lds + SW_PS + wave * SW_PSW;
    if (lane < 32) { const int row = lane >> 1, hf = lane & 1; *(LAS u32x4*)(Pw + row * 336 + 288 + hf * 16) = (u32x4){0u, 0u, 0u, 0u}; }
    __syncthreads();
    const LAS float* BT = (const LAS float*)(lds + SW_BT);
    for (int g = 0; g < 3; ++g) {
        const int hq = 3 * hk + g;
        const bf16_t* qrow = proj + (size_t)(128 * n + 16 * wave + l15) * PROJ_P + C_AQ + hq * 64 + 8 * g4;
        const bf16x8 a0 = *(const bf16x8*)qrow, a1 = *(const bf16x8*)(qrow + 32);
        f32x4 s[9];
#pragma unroll
        for (int jt = 0; jt < 9; ++jt) {
            const bf16x8 b0 = lds_frag_row(lds + SW_KS, 144, 16 * (wave + jt), 0, lane), b1 = lds_frag_row(lds + SW_KS, 144, 16 * (wave + jt), 32, lane);
            s[jt] = mfma16(a0, b0, (f32x4){0.f, 0.f, 0.f, 0.f}); s[jt] = mfma16(a1, b1, s[jt]);
        }
        const float sink = sinks[hq];
        float m[4] = {sink, sink, sink, sink};
#pragma unroll
        for (int jt = 0; jt < 9; ++jt)
#pragma unroll
            for (int i = 0; i < 4; ++i) {
                const int iq = 16 * wave + 4 * g4 + i, j = 16 * (wave + jt) + l15, dist = 128 + iq - j;
                const bool valid = (dist >= 0) && (dist < 128) && (n > 0 || j >= 128);
                const float lgt = valid ? s[jt][i] * 0.125f + BT[g * 128 + (dist & 127)] : -1e30f;
                s[jt][i] = lgt; m[i] = fmaxf(m[i], lgt);
            }
        float den[4];
#pragma unroll
        for (int i = 0; i < 4; ++i) {
            float mm = m[i];
            mm = fmaxf(mm, __shfl_xor(mm, 1)); mm = fmaxf(mm, __shfl_xor(mm, 2)); mm = fmaxf(mm, __shfl_xor(mm, 4)); mm = fmaxf(mm, __shfl_xor(mm, 8));
            m[i] = mm; den[i] = 0.f;
        }
#pragma unroll
        for (int jt = 0; jt < 9; ++jt)
#pragma unroll
            for (int i = 0; i < 4; ++i) { const float e = (s[jt][i] > -1e29f) ? __expf(s[jt][i] - m[i]) : 0.f; s[jt][i] = e; den[i] += e; }
#pragma unroll
        for (int i = 0; i < 4; ++i) {
            float d = den[i];
            d += __shfl_xor(d, 1); d += __shfl_xor(d, 2); d += __shfl_xor(d, 4); d += __shfl_xor(d, 8);
            den[i] = 1.0f / (d + __expf(sink - m[i]));
        }
#pragma unroll
        for (int jt = 0; jt < 9; ++jt)
#pragma unroll
            for (int i = 0; i < 4; ++i) *(LAS bf16_t*)(Pw + (4 * g4 + i) * 336 + (16 * jt + l15) * 2) = (bf16_t)f2bf(s[jt][i] * den[i]);
        LDS_WAIT();
        f32x4 o[4];
#pragma unroll
        for (int d = 0; d < 4; ++d) o[d] = (f32x4){0.f, 0.f, 0.f, 0.f};
#pragma unroll
        for (int ks = 0; ks < 5; ++ks) {
            const bf16x8 a = lds_frag_row(Pw, 336, 0, 32 * ks, lane);
#pragma unroll
            for (int d = 0; d < 4; ++d) { const bf16x8 b = lds_frag_tr(lds + SW_VS, 144, 16 * wave + 32 * ks, 16 * d, lane); o[d] = mfma16(a, b, o[d]); }
        }
#pragma unroll
        for (int d = 0; d < 4; ++d)
#pragma unroll
            for (int i = 0; i < 4; ++i) Oa[(size_t)(128 * n + 16 * wave + 4 * g4 + i) * 768 + hq * 64 + 16 * d + l15] = o[d][i];
        LDS_WAIT();
    }
    __syncthreads();
}

#ifndef PH_MASK
#define PH_MASK 0x1ff
#endif
#define HAS(k) (((PH_MASK) >> (k)) & 1)
struct Params { const float* in[15]; float* out; unsigned char* ws; int ph_lo, ph_hi; };
constexpr int N_PHASES = 16;

__global__ void __launch_bounds__(NTHREADS, 2) mega(Params p) {
    extern __shared__ __attribute__((aligned(16))) unsigned char lds_raw[];
    LAS unsigned char* lds = (LAS unsigned char*)lds_raw;
    cg::grid_group grid = cg::this_grid();
    const int G = gridDim.x;
    unsigned char* ws = p.ws;
    const float* x_in = p.in[0];
    float* xres = p.out;
    bf16_t* xb = (bf16_t*)(ws + WS_XB);
    float* rowss = (float*)(ws + WS_ROWSS);
    bf16_t* proj = (bf16_t*)(ws + WS_PROJ);
    float* Oa = (float*)(ws + WS_OA); float* Ob = (float*)(ws + WS_OB); float* Oc = (float*)(ws + WS_OC);
    float* dstate = (float*)(ws + WS_DSTATE); float* decay = (float*)(ws + WS_DECAY); bf16_t* sprev = (bf16_t*)(ws + WS_SPREV); bf16_t* qdec = (bf16_t*)(ws + WS_QDEC);
    bf16_t* mixed = (bf16_t*)(ws + WS_MIXED);
    bf16_t* hid = (bf16_t*)(ws + WS_HID);
#define IN(k) (p.ph_lo <= (k) && (k) < p.ph_hi)
#define SYNC(k) do { if (IN(k) && IN((k) + 1)) grid.sync(); } while (0)
#define PHASE_IDS() int tid = threadIdx.x; asm volatile("" : "+v"(tid)); const int lane = tid & 63, wave = __builtin_amdgcn_readfirstlane(tid >> 6), gw = blockIdx.x * NWAVES + wave, NGW = G * NWAVES; (void)lane; (void)gw; (void)NGW

    if (HAS(0) && IN(0)) {
        PHASE_IDS();
        LAS float* scr = (LAS float*)(lds + wave * 16640);
        constexpr int I_IN = 32 * (PROJ_P / 64), I_OUT = 32 * 32, I_1 = 32 * 128, I_2 = 128 * 32, I_L = I_IN + I_OUT + I_1 + I_2;
        for (int it = gw; it < DEPTH * I_L; it += NGW) {
            const int l = it / I_L; int r = it % I_L;
            unsigned char* wt = ws + WS_WT + (size_t)l * WT_LAYER;
            if (r < I_IN) { p0_transpose_item(p.in[2] + (size_t)l * DM * PROJ_W, DM, PROJ_W, p.in[1] + l * DM, (bf16_t*)(wt + WT_IN), 1, scr, r, lane); continue; } r -= I_IN;
            if (r < I_OUT) { p0_transpose_item(p.in[10] + (size_t)l * DM * DM, DM, DM, nullptr, (bf16_t*)(wt + WT_OUT), 0, scr, r, lane); continue; } r -= I_OUT;
            if (r < I_1) { p0_transpose_item(p.in[12] + (size_t)l * DM * DFF, DM, DFF, p.in[11] + l * DM, (bf16_t*)(wt + WT_1), 0, scr, r, lane); continue; } r -= I_1;
            p0_transpose_item(p.in[13] + (size_t)l * DFF * DM, DFF, DM, nullptr, (bf16_t*)(wt + WT_2), 0, scr, r, lane);
        }
        for (int m = gw; m < SEQ; m += NGW) {
            const f32x4* xr = (const f32x4*)(x_in + (size_t)m * DM) + lane;
            f32x4 v[8]; float ss = 0.f;
#pragma unroll
            for (int j = 0; j < 8; ++j) { v[j] = xr[64 * j]; ss += (v[j][0] * v[j][0] + v[j][1] * v[j][1]) + (v[j][2] * v[j][2] + v[j][3] * v[j][3]); }
            ss = wave_sum(ss);
            u32x2* o8 = (u32x2*)(xb + (size_t)m * DM) + lane;
#pragma unroll
            for (int j = 0; j < 8; ++j) { u32x2 w; w.x = pk2(v[j][0], v[j][1]); w.y = pk2(v[j][2], v[j][3]); o8[64 * j] = w; }
            if (lane < 32) rowss[(size_t)m * 32 + lane] = (lane == 0) ? ss : 0.f;
        }
    }
    SYNC(0);
    for (int l = 0; l < DEPTH; ++l) {
        const int pb = 1 + 7 * l;
        unsigned char* wt = ws + WS_WT + (size_t)l * WT_LAYER;
        if (HAS(1) && IN(pb + 0)) {
            pg8::Gemm g{xb, (const bf16_t*)(wt + WT_IN), SEQ, PROJ_P, DM}; pg8::StaticOrder S; S.init(SEQ, PROJ_P, G, (int)blockIdx.x);
            pg8::EpiScale<0> E{proj, PROJ_P, rowss};
            pg8::gemm_phase<pg8::EpiScale<0>, pg8::StaticOrder, true, true>(lds, g, S, E);
        }
        SYNC(pb + 0);
        if (HAS(2) && IN(pb + 1)) {
            PHASE_IDS();
            const float* gwt = p.in[5] + (size_t)l * 16 * 384; const float* gbs = p.in[6] + l * 384;
            for (int it = blockIdx.x; it < 512; it += G) gla_local_item(lds, proj, gwt, gbs, Ob, dstate, decay, qdec, it >> 2, it & 3, tid);
            const float* sinks = p.in[3] + l * 12; const float* relb = p.in[4];
            for (int it = blockIdx.x; it < 256; it += G) swa_item(lds, proj, sinks, relb, Oa, it >> 2, it & 3, tid);
            for (int it = blockIdx.x; it < 512; it += G) sb_item(lds, proj, Oc, it & 7, it >> 3, tid);
        }
        SYNC(pb + 1);
        if (HAS(3) && IN(pb + 2)) {
            PHASE_IDS();
            const int per = (73728 + G - 1) / G, e1 = min((int)(blockIdx.x + 1) * per, 73728);
            for (int e = blockIdx.x * per + tid; e < e1; e += NTHREADS) gla_scan_elem(dstate, decay, sprev, e);
        }
        SYNC(pb + 2);
        if (HAS(4) && IN(pb + 3)) {
            PHASE_IDS();
            const float* gA = p.in[8] + l * 768; const float* gB = p.in[7] + l * 192; const float* gC = p.in[9] + l * 512;
            for (int it = blockIdx.x; it < 512; it += G) gla_out_item(lds, proj, qdec, sprev, Ob, gB, mixed, it >> 2, it & 3, tid);
            for (int t = gw; t < SEQ; t += NGW) norm_ac_row(Oa, Oc, gA, gC, mixed, t, lane);
        }
        SYNC(pb + 3);
        if (HAS(5) && IN(pb + 4)) {
            pg8::Gemm g{mixed, (const bf16_t*)(wt + WT_OUT), SEQ, DM, DM}; pg8::StaticOrder S; S.init(SEQ, DM, G, (int)blockIdx.x);
            pg8::EpiResid E{l == 0 ? x_in : xres, xres, xb, rowss};
            pg8::gemm_phase<pg8::EpiResid, pg8::StaticOrder, true, true>(lds, g, S, E);
        }
        SYNC(pb + 4);
        if (HAS(6) && IN(pb + 5)) {
            pg8::Gemm g{xb, (const bf16_t*)(wt + WT_1), SEQ, DFF, DM}; pg8::StaticOrder S; S.init(SEQ, DFF, G, (int)blockIdx.x);
            pg8::EpiScale<1> E{hid, DFF, rowss};
            pg8::gemm_phase<pg8::EpiScale<1>, pg8::StaticOrder, true, true>(lds, g, S, E);
        }
        SYNC(pb + 5);
        if (HAS(7) && IN(pb + 6)) {
            pg8::Gemm g{hid, (const bf16_t*)(wt + WT_2), SEQ, DM, DFF}; pg8::StaticOrder S; S.init(SEQ, DM, G, (int)blockIdx.x);
            pg8::EpiResid E{xres, xres, xb, rowss};
            pg8::gemm_phase<pg8::EpiResid, pg8::StaticOrder, true, true>(lds, g, S, E);
        }
        SYNC(pb + 6);
    }
    if (HAS(8) && IN(N_PHASES - 1)) {
        PHASE_IDS();
        const float* gF = p.in[14];
        for (int m = gw; m < SEQ; m += NGW) {
            const float part = (lane < 32) ? rowss[(size_t)m * 32 + lane] : 0.f;
            const float rstd = rsqrtf(wave_sum(part) * (1.0f / 2048.0f) + RMS_EPS);
            f32x4* xr = (f32x4*)(xres + (size_t)m * DM) + lane;
            const f32x4* gr = (const f32x4*)gF + lane;
#pragma unroll
            for (int j = 0; j < 8; ++j) { f32x4 v = xr[64 * j]; const f32x4 g = gr[64 * j]; v = v * rstd * g; xr[64 * j] = v; }
        }
    }
}

#ifndef MK_N_LAUNCHES
#define MK_N_LAUNCHES 1
#endif
extern "C" void kernel_launch(void* const* d_in, const int* in_sizes, int n_in, void* d_out, int out_size, void* d_ws, size_t ws_size, hipStream_t stream) {
    static int grid = 0;
    if (grid == 0) {
        if (n_in != 15 || out_size != SEQ * DM || ws_size < WS_END) { fprintf(stderr, "kernel_launch: unexpected shapes (n_in %d out %d ws %zu)\n", n_in, out_size, ws_size); grid = -1; return; }
        int dev = 0, cus = 0, per_cu = 0;
        hipGetDevice(&dev);
        hipDeviceGetAttribute(&cus, hipDeviceAttributeMultiprocessorCount, dev);
        hipFuncSetAttribute((const void*)mega, hipFuncAttributeMaxDynamicSharedMemorySize, LDS_BYTES);
        hipOccupancyMaxActiveBlocksPerMultiprocessor(&per_cu, (const void*)mega, NTHREADS, LDS_BYTES);
        if (per_cu < 1) { fprintf(stderr, "kernel_launch: occupancy query says %d blocks/CU\n", per_cu); per_cu = 1; }
        (void)hipGetLastError();
        grid = cus * 1;
    }
    if (grid < 0) return;
    Params p{};
    for (int i = 0; i < 15; ++i) p.in[i] = (const float*)d_in[i];
    p.out = (float*)d_out; p.ws = (unsigned char*)d_ws;
    if (MK_N_LAUNCHES == 1) {
        p.ph_lo = 0; p.ph_hi = N_PHASES;
        void* args[] = {&p};
        hipError_t e = hipLaunchCooperativeKernel((const void*)mega, dim3(grid), dim3(NTHREADS), args, LDS_BYTES, stream);
        if (e != hipSuccess) fprintf(stderr, "cooperative launch failed: %s (grid %d)\n", hipGetErrorString(e), grid);
    } else {
        for (int ph = 0; ph < N_PHASES; ++ph) {
            p.ph_lo = ph; p.ph_hi = ph + 1;
            hipLaunchKernelGGL(mega, dim3(grid), dim3(NTHREADS), LDS_BYTES, stream, p);
        }
    }
}
```

```cpp
#include <hip/hip_runtime.h>
#include <hip/hip_cooperative_groups.h>
#include <cstdio>
#include <cstdint>
namespace cg = cooperative_groups;
namespace pg8 {
#define PG8_LAS __attribute__((address_space(3)))
typedef unsigned short bf16_t;
typedef short bf16x8 __attribute__((ext_vector_type(8)));
typedef float f32x4 __attribute__((ext_vector_type(4)));
typedef unsigned u32x4 __attribute__((ext_vector_type(4)));
constexpr int BM = 256, BK = 64, HALF = 128, HTB = HALF * BK * 2  , STAGE_BYTES = 8 * HTB, NXCD = 8, WGM = 8;

__host__ __device__ __forceinline__ int lds_byte(int r, int c) { const int st = (r >> 4) * 2 + (c >> 5), rr = r & 15, cc = c & 31, ob = rr * 64 + cc * 2; return st * 1024 + (ob ^ (((ob >> 9) & 1) << 5)); }
__host__ __device__ __forceinline__ void stage_rc(int b, int& R, int& C) { const int st = b / 1024, sb = b % 1024, swz = sb ^ (((sb >> 9) & 1) << 5); R = (st >> 1) * 16 + swz / 64; C = (st & 1) * 32 + (swz % 64) / 2; }
__host__ __device__ __forceinline__ int perm32(int rho) { const int n = rho >> 4, i = rho & 15; return 8 * (i >> 2) + 4 * n + (i & 3); }

struct Unit { int pm, pn; };
struct Gemm { const bf16_t* A; const bf16_t* Bt; int M, N, K; };

struct StaticOrder {
    int nM, nN, nwg, G, c;
    __host__ __device__ void init(int M, int N, int G_, int c_) { nM = M / BM; nN = N / BM; nwg = nM * nN; G = G_; c = c_; }
    __host__ __device__ bool next(int i, Unit& u) const {
        const long L = (long)i * G + c; if (L >= nwg) return false;
        int wgid = (int)L; { const int q = nwg / NXCD, r = nwg % NXCD, xcd = wgid % NXCD, off = wgid / NXCD; wgid = (xcd < r ? xcd * (q + 1) : r * (q + 1) + (xcd - r) * q) + off; }
        const int nig = WGM * nN, gid = wgid / nig, fm = gid * WGM, gsz = (nM - fm) < WGM ? (nM - fm) : WGM;
        u.pm = fm + ((wgid % nig) % gsz); u.pn = (wgid % nig) / gsz; return true;
    }
    __device__ __forceinline__ void a_ready(const Unit&) const {}
    __device__ __forceinline__ void done(const Unit&) const {}
};
__device__ __forceinline__ unsigned cvt_pk_bf16(float lo, float hi) { unsigned r; asm volatile("v_cvt_pk_bf16_f32 %0, %1, %2" : "=v"(r) : "v"(lo), "v"(hi)); return r; }
typedef float f32x2 __attribute__((ext_vector_type(2)));
template <class Epi, class Sched, bool ALIGN_EPI = false, bool SP2 = false>
__device__ __forceinline__ void gemm_phase(PG8_LAS unsigned char* lds, const Gemm g, const Sched& S, const Epi& E) {
    int tid_ = threadIdx.x; asm volatile("" : "+v"(tid_));
    const int tid = tid_, wid = __builtin_amdgcn_readfirstlane(tid >> 6), lane = tid & 63, wr = wid >> 2, wc = wid & 3, fr = lane & 15, fq = lane >> 4;
    const int K = g.K, nt = K / BK;
    unsigned voffA[2], voffB[2];
#pragma unroll
    for (int i = 0; i < 2; ++i) { int R, C; stage_rc(tid * 16 + i * 8192, R, C); const int Rb = Epi::PERM ? ((R & ~31) + perm32(R & 31)) : R;
        voffA[i] = (unsigned)(R * K + C) * 2u; voffB[i] = (unsigned)(Rb * K + C) * 2u; }
    const size_t kstep = (size_t)(BK * 2);
    const size_t hstep = (size_t)HALF * K * 2;
    const size_t tstep = 2 * hstep;
    const unsigned ldsw = (unsigned)wid * 1024u;
    const int aoff = lds_byte(wr * 64 + fr, fq * 8), boff = lds_byte(wc * 32 + fr, fq * 8);
#define PG8_SA(b, h) (((b) * 2 + (h)) * HTB)
#define PG8_SB(b, h) ((4 + (b) * 2 + (h)) * HTB)
#define PG8_STAGE(bufoff, gbase, voff) do { _Pragma("unroll") for (int _i = 0; _i < 2; ++_i) \
        __builtin_amdgcn_global_load_lds((const unsigned*)((const char*)(gbase) + (voff)[_i]), (PG8_LAS unsigned*)(lds + (bufoff) + ldsw + _i * 8192), 16, 0, 0); } while (0)
#define PG8_LDA(dst, b, h) do { _Pragma("unroll") for (int m = 0; m < 4; ++m) _Pragma("unroll") for (int k = 0; k < 2; ++k) dst[m][k] = *(const PG8_LAS bf16x8*)(lds + PG8_SA(b, h) + aoff + m * 2048 + k * 1024); } while (0)
#define PG8_LDB(dst, b, h) do { _Pragma("unroll") for (int n = 0; n < 2; ++n) _Pragma("unroll") for (int k = 0; k < 2; ++k) dst[n][k] = *(const PG8_LAS bf16x8*)(lds + PG8_SB(b, h) + boff + n * 2048 + k * 1024); } while (0)
#define PG8_MMA(ai, bj, At, Bt) do { __builtin_amdgcn_s_setprio(1); _Pragma("unroll") for (int m = 0; m < 4; ++m) _Pragma("unroll") for (int n = 0; n < 2; ++n) _Pragma("unroll") for (int k = 0; k < 2; ++k) \
        acc[ai][bj][m][n] = __builtin_amdgcn_mfma_f32_16x16x32_bf16(Bt[n][k], At[m][k], acc[ai][bj][m][n], 0, 0, 0); __builtin_amdgcn_s_setprio(0); } while (0)
#define PG8_WAIT_V(n) asm volatile("s_waitcnt vmcnt(" #n ")" ::: "memory")
#define PG8_WAIT_L(n) asm volatile("s_waitcnt lgkmcnt(" #n ")" ::: "memory")
#define PG8_BAR __builtin_amdgcn_s_barrier()
#define PG8_SCHED __builtin_amdgcn_sched_barrier(0)
    Unit cur, nxt; int ui = 0;
    if (!S.next(0, cur)) return;
    f32x4 acc[2][2][4][2];
#pragma unroll
    for (int a = 0; a < 2; ++a)
#pragma unroll
        for (int b = 0; b < 2; ++b)
#pragma unroll
            for (int m = 0; m < 4; ++m)
#pragma unroll
                for (int n = 0; n < 2; ++n) acc[a][b][m][n] = (f32x4){0.f, 0.f, 0.f, 0.f};
    bf16x8 At[4][2], B0[2][2], B1[2][2];
    const char* cA = (const char*)g.A + (size_t)cur.pm * tstep; const char* cB = (const char*)g.Bt + (size_t)cur.pn * tstep;
    S.a_ready(cur);
    if constexpr (SP2) {
        PG8_STAGE(PG8_SB(0, 0), cB, voffB); PG8_STAGE(PG8_SB(0, 1), cB + hstep, voffB); PG8_STAGE(PG8_SA(0, 0), cA, voffA); PG8_STAGE(PG8_SA(0, 1), cA + hstep, voffA);
        if (wr == 1) PG8_BAR;
        PG8_WAIT_V(2); PG8_BAR;
        PG8_STAGE(PG8_SB(1, 0), cB + kstep, voffB); PG8_STAGE(PG8_SA(1, 0), cA + kstep, voffA); PG8_STAGE(PG8_SB(1, 1), cB + hstep + kstep, voffB);
        PG8_WAIT_V(6); PG8_BAR;
    } else {
        PG8_STAGE(PG8_SB(0, 0), cB, voffB); PG8_STAGE(PG8_SA(0, 0), cA, voffA); PG8_STAGE(PG8_SB(0, 1), cB + hstep, voffB); PG8_STAGE(PG8_SA(0, 1), cA + hstep, voffA);
        if (wr == 1) PG8_BAR;
        PG8_WAIT_V(4); PG8_BAR;
        PG8_STAGE(PG8_SB(1, 0), cB + kstep, voffB); PG8_STAGE(PG8_SA(1, 0), cA + kstep, voffA); PG8_STAGE(PG8_SB(1, 1), cB + hstep + kstep, voffB);
        PG8_WAIT_V(6); PG8_BAR;
    }
    for (;;) {
        const bool has_next = S.next(ui + 1, nxt);
        const char* nA = has_next ? (const char*)g.A + (size_t)nxt.pm * tstep : cA; const char* nB = has_next ? (const char*)g.Bt + (size_t)nxt.pn * tstep : cB;
        for (int t = 0; t < nt; t += 2) {
            const bool last = (t == nt - 2);
            const char* a1 = cA + (size_t)(t + 1) * kstep;
            const char* a2 = last ? nA : cA + (size_t)(t + 2) * kstep; const char* b2 = last ? nB : cB + (size_t)(t + 2) * kstep;
            const char* a3 = a2 + kstep; const char* b3 = b2 + kstep;
            if (last && has_next) S.a_ready(nxt);
            if constexpr (SP2) {
            PG8_LDB(B0, 0, 0); PG8_LDB(B1, 0, 1); PG8_SCHED; PG8_LDA(At, 0, 0); PG8_STAGE(PG8_SA(1, 1), a1 + hstep, voffA);
            PG8_WAIT_V(8); PG8_WAIT_L(0); PG8_BAR; PG8_MMA(0, 0, At, B0); PG8_MMA(0, 1, At, B1); PG8_BAR; PG8_SCHED;
            PG8_LDA(At, 0, 1); PG8_STAGE(PG8_SB(0, 0), b2, voffB); PG8_STAGE(PG8_SB(0, 1), b2 + hstep, voffB); PG8_STAGE(PG8_SA(0, 0), a2, voffA);
            PG8_WAIT_V(8); PG8_WAIT_L(0); PG8_BAR; PG8_MMA(1, 0, At, B0); PG8_MMA(1, 1, At, B1); PG8_BAR; PG8_SCHED;
            PG8_LDB(B0, 1, 0); PG8_LDB(B1, 1, 1); PG8_SCHED; PG8_LDA(At, 1, 0); PG8_STAGE(PG8_SA(0, 1), a2 + hstep, voffA);
            PG8_WAIT_V(8); PG8_WAIT_L(0); PG8_BAR; PG8_MMA(0, 0, At, B0); PG8_MMA(0, 1, At, B1); PG8_BAR; PG8_SCHED;
            PG8_LDA(At, 1, 1); PG8_STAGE(PG8_SB(1, 0), b3, voffB); PG8_STAGE(PG8_SB(1, 1), b3 + hstep, voffB); PG8_STAGE(PG8_SA(1, 0), a3, voffA);
            PG8_WAIT_V(8); PG8_WAIT_L(0); PG8_BAR; PG8_MMA(1, 0, At, B0); PG8_MMA(1, 1, At, B1); PG8_BAR; PG8_SCHED;
            } else {
            PG8_LDB(B0, 0, 0); PG8_SCHED; PG8_LDA(At, 0, 0); PG8_STAGE(PG8_SA(1, 1), a1 + hstep, voffA);
            PG8_WAIT_L(8); PG8_BAR; PG8_WAIT_L(0); PG8_MMA(0, 0, At, B0); PG8_BAR; PG8_SCHED;
            PG8_LDB(B1, 0, 1); PG8_STAGE(PG8_SB(0, 0), b2, voffB);
            PG8_BAR; PG8_WAIT_L(0); PG8_MMA(0, 1, At, B1); PG8_BAR;
            PG8_LDA(At, 0, 1); PG8_STAGE(PG8_SA(0, 0), a2, voffA);
            PG8_BAR; PG8_WAIT_L(0); PG8_MMA(1, 0, At, B0); PG8_BAR; PG8_SCHED;
            PG8_STAGE(PG8_SB(0, 1), b2 + hstep, voffB);
            PG8_WAIT_V(6); PG8_BAR; PG8_MMA(1, 1, At, B1); PG8_BAR;
            PG8_LDB(B0, 1, 0); PG8_SCHED; PG8_LDA(At, 1, 0); PG8_STAGE(PG8_SA(0, 1), a2 + hstep, voffA);
            PG8_WAIT_L(8); PG8_BAR; PG8_WAIT_L(0); PG8_MMA(0, 0, At, B0); PG8_BAR; PG8_SCHED;
            PG8_LDB(B1, 1, 1); PG8_STAGE(PG8_SB(1, 0), b3, voffB);
            PG8_BAR; PG8_WAIT_L(0); PG8_MMA(0, 1, At, B1); PG8_BAR;
            PG8_LDA(At, 1, 1); PG8_STAGE(PG8_SA(1, 0), a3, voffA);
            PG8_BAR; PG8_WAIT_L(0); PG8_MMA(1, 0, At, B0); PG8_BAR; PG8_SCHED;
            PG8_STAGE(PG8_SB(1, 1), b3 + hstep, voffB);
            PG8_WAIT_V(6); PG8_BAR; PG8_MMA(1, 1, At, B1); PG8_BAR;
            }
        }
        if constexpr (ALIGN_EPI) { if (wr == 0) PG8_BAR; }
        if constexpr (!Epi::AFTER_DRAIN) { E(acc, cur, wr, wc, fr, fq); S.done(cur); }
        if (!has_next) break;
#pragma unroll
        for (int a = 0; a < 2; ++a)
#pragma unroll
            for (int b = 0; b < 2; ++b)
#pragma unroll
                for (int m = 0; m < 4; ++m)
#pragma unroll
                    for (int n = 0; n < 2; ++n) acc[a][b][m][n] = (f32x4){0.f, 0.f, 0.f, 0.f};
        cur = nxt; cA = nA; cB = nB; ++ui;
        if constexpr (ALIGN_EPI) { if (wr == 1) PG8_BAR; }
    }
    PG8_WAIT_V(0);
    if constexpr (!ALIGN_EPI) { if (wr == 0) PG8_BAR; }
    PG8_BAR;
    if constexpr (Epi::AFTER_DRAIN) { E.fused(acc, cur, wr, wc, fr, fq, lds, wid, lane); S.done(cur); }
#undef PG8_SA
#undef PG8_SB
#undef PG8_STAGE
#undef PG8_LDA
#undef PG8_LDB
#undef PG8_MMA
#undef PG8_WAIT_V
#undef PG8_WAIT_L
#undef PG8_BAR
#undef PG8_SCHED
}
}

#define LAS __attribute__((address_space(3)))
typedef unsigned short bf16_t;
typedef float f32x4 __attribute__((ext_vector_type(4)));
typedef unsigned u32x4 __attribute__((ext_vector_type(4)));
typedef unsigned u32x2 __attribute__((ext_vector_type(2)));
constexpr int SEQ = 8192, DM = 2048, DEPTH = 2, DFF = 8192;
constexpr int PROJ_W = 5136, PROJ_P = 5376;
constexpr int C_AQ = 0, C_AK = 768, C_AV = 1024, C_BQ = 1280, C_BK = 1664, C_BV = 2048, C_BR = 2816, C_CQ = 3584, C_CK = 4096, C_CV = 4608, C_LR = 5120;
constexpr float RMS_EPS = 1e-6f;
constexpr int NWAVES = 8, NTHREADS = 512;
constexpr int LDS_BYTES = 147456;

constexpr size_t MiB = 1u << 20;
constexpr size_t WS_CTL = 0;
constexpr size_t WS_ROWSS = 1 * MiB;
constexpr size_t WS_DECAY = 3 * MiB;
constexpr size_t WS_WT = 4 * MiB;
constexpr size_t WT_IN = 0, WT_OUT = 21 * MiB, WT_1 = 29 * MiB, WT_2 = 61 * MiB, WT_LAYER = 93 * MiB;
constexpr size_t WS_XB = 190 * MiB;
constexpr size_t WS_PROJ = 222 * MiB;
constexpr size_t WS_OA = 306 * MiB;
constexpr size_t WS_OC = 330 * MiB;
constexpr size_t WS_OB = 346 * MiB;
constexpr size_t WS_DSTATE = 370 * MiB;
constexpr size_t WS_SPREV = 406 * MiB;
constexpr size_t WS_QDEC = 424 * MiB;
constexpr size_t WS_MIXED = 430 * MiB;
constexpr size_t WS_HID = 222 * MiB;
constexpr size_t WS_END = 462 * MiB;

__device__ const unsigned char T5B[128] = {0, 1, 2, 3, 4, 5, 6, 7, 8, 9, 10, 11, 12, 13, 14, 15, 16, 16, 16, 17, 17, 18, 18, 18, 19, 19, 19, 20, 20, 20, 20, 21, 21, 21, 21, 22, 22, 22, 22, 22, 23, 23, 23, 23, 23, 23, 24, 24, 24, 24, 24, 24, 25, 25, 25, 25, 25, 25, 25, 26, 26, 26, 26, 26, 26, 26, 26, 27, 27, 27, 27, 27, 27, 27, 27, 27, 27, 28, 28, 28, 28, 28, 28, 28, 28, 28, 28, 29, 29, 29, 29, 29, 29, 29, 29, 29, 29, 29, 29, 30, 30, 30, 30, 30, 30, 30, 30, 30, 30, 30, 30, 30, 30, 31, 31, 31, 31, 31, 31, 31, 31, 31, 31, 31, 31, 31, 31, 31};

__device__ __forceinline__ float bf2f(bf16_t u) { return __uint_as_float((unsigned)u << 16); }
__device__ __forceinline__ float bflo(unsigned x) { return __uint_as_float(x << 16); }
__device__ __forceinline__ float bfhi(unsigned x) { return __uint_as_float(x & 0xffff0000u); }
typedef float f32x2_t __attribute__((ext_vector_type(2))); typedef __bf16 bf16x2_t __attribute__((ext_vector_type(2)));
__device__ __forceinline__ unsigned pk2(float lo, float hi) { f32x2_t v = {lo, hi}; bf16x2_t b = __builtin_convertvector(v, bf16x2_t); return __builtin_bit_cast(unsigned, b); }
__device__ __forceinline__ unsigned f2bf(float f) { return pk2(f, 0.f) & 0xffffu; }
__device__ __forceinline__ float wave_sum(float v) {
#pragma unroll
    for (int o = 1; o < 64; o <<= 1) v += __shfl_xor(v, o);
    return v;
}
__device__ __forceinline__ float wave_max(float v) {
#pragma unroll
    for (int o = 1; o < 64; o <<= 1) v = fmaxf(v, __shfl_xor(v, o));
    return v;
}
__device__ __forceinline__ float wave_incl_scan(float x, int lane) {
#pragma unroll
    for (int o = 1; o < 64; o <<= 1) { const float y = __shfl_up(x, o); if (lane >= o) x += y; }
    return x;
}
__device__ __forceinline__ float softplusf(float z) { return fmaxf(z, 0.f) + __logf(1.0f + __expf(-fabsf(z))); }
#define LDS_WAIT() asm volatile("s_waitcnt lgkmcnt(0)" ::: "memory")

namespace pg8 {
template <int ACT> struct EpiScale {
    static constexpr bool PERM = true, AFTER_DRAIN = false;
    bf16_t* O; int ldc; const float* rowss;
    __device__ __forceinline__ void operator()(const f32x4 (&acc)[2][2][4][2], const Unit& u, int wr, int wc, int fr, int fq) const {
        const int row0 = u.pm * BM + wr * 64 + fr, col0 = u.pn * BM + wc * 32 + 8 * fq;
#pragma unroll
        for (int ai = 0; ai < 2; ++ai)
#pragma unroll
            for (int m = 0; m < 4; ++m) {
                const int row = row0 + ai * HALF + m * 16;
                const f32x4* pp = (const f32x4*)(rowss + (size_t)row * 32 + fq * 8);
                const f32x4 pa = pp[0], pb = pp[1];
                float s = ((pa[0] + pa[1]) + (pa[2] + pa[3])) + ((pb[0] + pb[1]) + (pb[2] + pb[3]));
                s += __shfl_xor(s, 16); s += __shfl_xor(s, 32);
                const float rstd = rsqrtf(s * (1.0f / 2048.0f) + 1e-6f);
                bf16_t* rowp = O + (size_t)row * ldc + col0;
#pragma unroll
                for (int bj = 0; bj < 2; ++bj) {
                    f32x4 v0 = acc[ai][bj][m][0] * rstd, v1 = acc[ai][bj][m][1] * rstd;
                    if (ACT == 1) {
#pragma unroll
                        for (int e = 0; e < 4; ++e) { const float a = fmaxf(v0[e], 0.f), b = fmaxf(v1[e], 0.f); v0[e] = a * a; v1[e] = b * b; }
                    }
                    u32x4 w; w.x = cvt_pk_bf16(v0[0], v0[1]); w.y = cvt_pk_bf16(v0[2], v0[3]); w.z = cvt_pk_bf16(v1[0], v1[1]); w.w = cvt_pk_bf16(v1[2], v1[3]);
                    *(u32x4*)(rowp + bj * HALF) = w;
                }
            }
    }
};
struct EpiResid {
    static constexpr bool PERM = true, AFTER_DRAIN = false;
    bf16_t* xb; float* rowss;
    __device__ __forceinline__ void operator()(const f32x4 (&acc)[2][2][4][2], const Unit& u, int wr, int wc, int fr, int fq) const {
        const int row0 = u.pm * BM + wr * 64 + fr, col0 = u.pn * BM + wc * 32 + 8 * fq;
#pragma unroll
        for (int ai = 0; ai < 2; ++ai)
#pragma unroll
            for (int m = 0; m < 4; ++m) {
                const int row = row0 + ai * HALF + m * 16;
                const size_t off = (size_t)row * 2048 + col0;
                float ss = 0.f;
#pragma unroll
                for (int bj = 0; bj < 2; ++bj) {
                    const u32x4 ob = *(const u32x4*)(xb + off + bj * HALF);
                    f32x4 o0 = (f32x4){__uint_as_float(ob.x << 16), __uint_as_float(ob.x & 0xffff0000u), __uint_as_float(ob.y << 16), __uint_as_float(ob.y & 0xffff0000u)};
                    f32x4 o1 = (f32x4){__uint_as_float(ob.z << 16), __uint_as_float(ob.z & 0xffff0000u), __uint_as_float(ob.w << 16), __uint_as_float(ob.w & 0xffff0000u)};
                    o0 += acc[ai][bj][m][0]; o1 += acc[ai][bj][m][1];
                    ss += ((o0[0] * o0[0] + o0[1] * o0[1]) + (o0[2] * o0[2] + o0[3] * o0[3])) + ((o1[0] * o1[0] + o1[1] * o1[1]) + (o1[2] * o1[2] + o1[3] * o1[3]));
                    u32x4 w; w.x = cvt_pk_bf16(o0[0], o0[1]); w.y = cvt_pk_bf16(o0[2], o0[3]); w.z = cvt_pk_bf16(o1[0], o1[1]); w.w = cvt_pk_bf16(o1[2], o1[3]);
                    *(u32x4*)(xb + off + bj * HALF) = w;
                }
                ss += __shfl_xor(ss, 16); ss += __shfl_xor(ss, 32);
                if (fq == 0) rowss[(size_t)row * 32 + u.pn * 4 + wc] = ss;
            }
    }
};
}


typedef short bf16x8 __attribute__((ext_vector_type(8)));
typedef short s16x4 __attribute__((ext_vector_type(4)));
__device__ __forceinline__ f32x4 mfma16(bf16x8 a, bf16x8 b, f32x4 c) { return __builtin_amdgcn_mfma_f32_16x16x32_bf16(a, b, c, 0, 0, 0); }
__device__ __forceinline__ bf16x8 lds_frag_row(const LAS unsigned char* base, int stride, int r0, int k0, int lane) {
    return *(const LAS bf16x8*)(base + (r0 + (lane & 15)) * stride + (k0 + 8 * (lane >> 4)) * 2);
}
__device__ __forceinline__ bf16x8 lds_frag_tr(const LAS unsigned char* base, int stride, int k0, int c0, int lane) {
    const int g = lane >> 4, i = lane & 15;
    const LAS unsigned char* p = base + (k0 + 8 * g + (i >> 2)) * stride + (c0 + 4 * (i & 3)) * 2;
    const s16x4 lo = __builtin_bit_cast(s16x4, __builtin_amdgcn_ds_read_tr16_b64_v4i16((LAS s16x4*)p));
    const s16x4 hi = __builtin_bit_cast(s16x4, __builtin_amdgcn_ds_read_tr16_b64_v4i16((LAS s16x4*)(p + 4 * stride)));
    return (bf16x8){lo[0], lo[1], lo[2], lo[3], hi[0], hi[1], hi[2], hi[3]};
}

__device__ __forceinline__ bf16x8 lds_frag_trp(const LAS unsigned char* base, int stride, int k0, int c0, int p, int lane) {
    const int g = lane >> 4, i = lane & 15;
    const LAS unsigned char* q = base + (k0 + 8 * g + (i >> 2)) * stride + (c0 + 8 * (i & 3) + 4 * p) * 2;
    const s16x4 lo = __builtin_bit_cast(s16x4, __builtin_amdgcn_ds_read_tr16_b64_v4i16((LAS s16x4*)q));
    const s16x4 hi = __builtin_bit_cast(s16x4, __builtin_amdgcn_ds_read_tr16_b64_v4i16((LAS s16x4*)(q + 4 * stride)));
    return (bf16x8){lo[0], lo[1], lo[2], lo[3], hi[0], hi[1], hi[2], hi[3]};
}
__device__ __forceinline__ u32x4 pack8(const f32x4 a, const f32x4 c) { return (u32x4){pk2(a[0], a[1]), pk2(a[2], a[3]), pk2(c[0], c[1]), pk2(c[2], c[3])}; }

constexpr int GL_LG = 0, GL_QD = 24832, GL_KI = 38144, GL_KE = 51456, GL_VS = 64768, GL_SC = 90368, GL_BLR = 99584, GL_GW = 103680, GL_BL = 109824;
__device__ __forceinline__ void gla_local_item(LAS unsigned char* lds, const bf16_t* __restrict__ proj, const float* __restrict__ gwt  , const float* __restrict__ gbs  ,
                                               bf16_t* __restrict__ Ob, float* __restrict__ dstate, float* __restrict__ decay, bf16_t* __restrict__ qdec, int n, int h, int tid) {
    const int lane = tid & 63, wave = __builtin_amdgcn_readfirstlane(tid >> 6), g4 = lane >> 4, l15 = lane & 15;
    const int t0 = 64 * n;
    LAS float* lg = (LAS float*)(lds + GL_LG); LAS float* bl = (LAS float*)(lds + GL_BL);
    if (tid < 256) {
        const int row = tid >> 2, q = tid & 3;
        u32x4 v = (u32x4){0u, 0u, 0u, 0u};
        if (q < 2) v = *(const u32x4*)(proj + (size_t)(t0 + row) * PROJ_P + C_LR + 8 * q);
        *(LAS u32x4*)(lds + GL_BLR + row * 64 + q * 16) = v;
    }
    for (int i = tid; i < 96 * 32; i += NTHREADS) { const int c = i >> 5, r = i & 31; *(LAS bf16_t*)(lds + GL_GW + i * 2) = (bf16_t)((r < 16) ? f2bf(gwt[r * 384 + h * 96 + c]) : 0u); }
#pragma unroll
    for (int i = 0; i < 3; ++i) {
        const int id = tid + NTHREADS * i, row = id / 24, ch = id % 24;
        const u32x4 v = *(const u32x4*)(proj + (size_t)(t0 + row) * PROJ_P + C_BV + h * 192 + 8 * ch);
        *(LAS u32x4*)(lds + GL_VS + row * 400 + ch * 16) = v;
    }
    __syncthreads();
    {
        const int rt = wave >> 1;
        const bf16x8 a = lds_frag_row(lds + GL_BLR, 64, 16 * rt, 0, lane);
#pragma unroll
        for (int c = 0; c < 3; ++c) {
            const int ct = 3 * (wave & 1) + c;
            const bf16x8 bfr = lds_frag_row(lds + GL_GW, 64, 16 * ct, 0, lane);
            const f32x4 acc = mfma16(a, bfr, (f32x4){0.f, 0.f, 0.f, 0.f});
            const int k = 16 * ct + l15; const float gb = gbs[h * 96 + k];
#pragma unroll
            for (int i = 0; i < 4; ++i) {
                const float gp = acc[i] + gb;
                const float ls = fminf(gp, 0.f) - __logf(1.0f + __expf(-fabsf(gp)));
                lg[(16 * rt + 4 * g4 + i) * 97 + k] = fmaxf(ls * (1.0f / 16.0f), -1.0f);
            }
        }
    }
    __syncthreads();
    if (tid < 384) {
        const int k = tid >> 2, part = tid & 3;
        float run = 0.f;
#pragma unroll
        for (int i = 0; i < 16; ++i) { run += lg[(16 * part + i) * 97 + k]; lg[(16 * part + i) * 97 + k] = run; }
        const float o1 = __shfl_up(run, 1), o2 = __shfl_up(run, 2), o3 = __shfl_up(run, 3);
        const float off = (part >= 1 ? o1 : 0.f) + (part >= 2 ? o2 : 0.f) + (part >= 3 ? o3 : 0.f);
#pragma unroll
        for (int i = 0; i < 16; ++i) lg[(16 * part + i) * 97 + k] += off;
        if (part == 3) bl[k] = run + off;
    }
    __syncthreads();
#pragma unroll
    for (int it = 0; it < 3; ++it) {
        const int id = tid + NTHREADS * it, t = id / 24, k4 = (id % 24) * 4;
        const bf16_t* row = proj + (size_t)(t0 + t) * PROJ_P + h * 96 + k4;
        const u32x2 qv = *(const u32x2*)(row + C_BQ), kv = *(const u32x2*)(row + C_BK);
        const float q[4] = {bflo(qv.x), bfhi(qv.x), bflo(qv.y), bfhi(qv.y)}, kk[4] = {bflo(kv.x), bfhi(kv.x), bflo(kv.y), bfhi(kv.y)};
        float qd[4], ki[4], ke[4];
#pragma unroll
        for (int e = 0; e < 4; ++e) {
            const float bb = lg[t * 97 + k4 + e];
            qd[e] = q[e] * 0.10206207261596577f * __expf(bb); ki[e] = kk[e] * __expf(-bb); ke[e] = kk[e] * __expf(bl[k4 + e] - bb);
        }
        const u32x2 qdp = (u32x2){pk2(qd[0], qd[1]), pk2(qd[2], qd[3])};
        *(LAS u32x2*)(lds + GL_QD + t * 208 + k4 * 2) = qdp;
        *(LAS u32x2*)(lds + GL_KI + t * 208 + k4 * 2) = (u32x2){pk2(ki[0], ki[1]), pk2(ki[2], ki[3])};
        *(LAS u32x2*)(lds + GL_KE + t * 208 + k4 * 2) = (u32x2){pk2(ke[0], ke[1]), pk2(ke[2], ke[3])};
        *(u32x2*)(qdec + (size_t)(t0 + t) * 384 + h * 96 + k4) = qdp;
    }
    if (tid < 96) decay[(n * 4 + h) * 96 + tid] = __expf(bl[tid]);
    __syncthreads();
    {
        const int rt = wave >> 1;
        f32x4 acc[2] = {(f32x4){0.f, 0.f, 0.f, 0.f}, (f32x4){0.f, 0.f, 0.f, 0.f}};
#pragma unroll
        for (int ks = 0; ks < 3; ++ks) {
            const bf16x8 qf = lds_frag_row(lds + GL_QD, 208, 16 * rt, 32 * ks, lane);
#pragma unroll
            for (int c = 0; c < 2; ++c) { const bf16x8 kf = lds_frag_row(lds + GL_KI, 208, 16 * (2 * (wave & 1) + c), 32 * ks, lane); acc[c] = mfma16(kf, qf, acc[c]); }
        }
        const int t = 16 * rt + l15;
#pragma unroll
        for (int c = 0; c < 2; ++c) {
            const int s = 16 * (2 * (wave & 1) + c) + 4 * g4;
            const float v0 = (s + 0 <= t) ? acc[c][0] : 0.f, v1 = (s + 1 <= t) ? acc[c][1] : 0.f, v2 = (s + 2 <= t) ? acc[c][2] : 0.f, v3 = (s + 3 <= t) ? acc[c][3] : 0.f;
            *(LAS u32x2*)(lds + GL_SC + t * 144 + s * 2) = (u32x2){pk2(v0, v1), pk2(v2, v3)};
        }
    }
    __syncthreads();
    {
        const int rt = wave >> 1;
        const bf16x8 s0 = lds_frag_row(lds + GL_SC, 144, 16 * rt, 0, lane), s1 = lds_frag_row(lds + GL_SC, 144, 16 * rt, 32, lane);
#pragma unroll
        for (int c = 0; c < 3; ++c) {
            const int cp = 3 * (wave & 1) + c;
            f32x4 acc[2];
#pragma unroll
            for (int pp = 0; pp < 2; ++pp) {
                const bf16x8 v0 = lds_frag_trp(lds + GL_VS, 400, 0, 32 * cp, pp, lane), v1 = lds_frag_trp(lds + GL_VS, 400, 32, 32 * cp, pp, lane);
                acc[pp] = mfma16(v0, s0, (f32x4){0.f, 0.f, 0.f, 0.f}); acc[pp] = mfma16(v1, s1, acc[pp]);
            }
            *(u32x4*)(Ob + (size_t)(t0 + 16 * rt + l15) * 768 + h * 192 + 32 * cp + 8 * g4) = pack8(acc[0], acc[1]);
        }
#pragma unroll
        for (int c = 0; c < 9; ++c) {
            const int T = wave * 9 + c, kt = T / 12, ct = T % 12;
            const bf16x8 a0 = lds_frag_tr(lds + GL_KE, 208, 0, 16 * kt, lane), a1 = lds_frag_tr(lds + GL_KE, 208, 32, 16 * kt, lane);
            const bf16x8 b0 = lds_frag_tr(lds + GL_VS, 400, 0, 16 * ct, lane), b1 = lds_frag_tr(lds + GL_VS, 400, 32, 16 * ct, lane);
            f32x4 acc = mfma16(a0, b0, (f32x4){0.f, 0.f, 0.f, 0.f}); acc = mfma16(a1, b1, acc);
            *(f32x4*)(dstate + ((size_t)(n * 4 + h) * 192 + 16 * ct + l15) * 96 + 16 * kt + 4 * g4) = acc;
        }
    }
    __syncthreads();
}
__device__ __forceinline__ void gla_scan_elem(const float* __restrict__ dstate, const float* __restrict__ decay, bf16_t* __restrict__ sprev, int e) {
    const int h = e / 18432, dk = e % 96;
    float S = 0.f;
    for (int n0 = 0; n0 < 128; n0 += 16) {
        float ds[16], dc[16];
#pragma unroll
        for (int u = 0; u < 16; ++u) { ds[u] = dstate[(size_t)(n0 + u) * 73728 + e]; dc[u] = decay[((n0 + u) * 4 + h) * 96 + dk]; }
#pragma unroll
        for (int u = 0; u < 16; ++u) { sprev[(size_t)(n0 + u) * 73728 + e] = (bf16_t)f2bf(S); S = dc[u] * S + ds[u]; }
    }
}
__device__ __forceinline__ void gla_out_task(const bf16_t* __restrict__ proj, const bf16_t* __restrict__ qdec, const bf16_t* __restrict__ sprev, const bf16_t* __restrict__ Ob,
                                             const float* __restrict__ gB, bf16_t* __restrict__ mixed, int n, int h, int rt, int lane) {
    const int g4 = lane >> 4, l15 = lane & 15;
    const int t = 64 * n + 16 * rt + l15;
    bf16x8 qf[3];
#pragma unroll
    for (int ks = 0; ks < 3; ++ks) qf[ks] = *(const bf16x8*)(qdec + (size_t)t * 384 + h * 96 + 32 * ks + 8 * g4);
    f32x4 o[6][2]; float ss = 0.f;
#pragma unroll
    for (int cp = 0; cp < 6; ++cp) {
        const u32x4 ow = *(const u32x4*)(Ob + (size_t)t * 768 + h * 192 + 32 * cp + 8 * g4);
        o[cp][0] = (f32x4){bflo(ow.x), bfhi(ow.x), bflo(ow.y), bfhi(ow.y)}; o[cp][1] = (f32x4){bflo(ow.z), bfhi(ow.z), bflo(ow.w), bfhi(ow.w)};
#pragma unroll
        for (int pp = 0; pp < 2; ++pp) {
            const int dvrow = 32 * cp + 8 * (l15 >> 2) + 4 * pp + (l15 & 3);
            const bf16_t* sp = sprev + ((size_t)(n * 4 + h) * 192 + dvrow) * 96 + 8 * g4;
#pragma unroll
            for (int ks = 0; ks < 3; ++ks) o[cp][pp] = mfma16(*(const bf16x8*)(sp + 32 * ks), qf[ks], o[cp][pp]);
            ss += (o[cp][pp][0] * o[cp][pp][0] + o[cp][pp][1] * o[cp][pp][1]) + (o[cp][pp][2] * o[cp][pp][2] + o[cp][pp][3] * o[cp][pp][3]);
        }
    }
    ss += __shfl_xor(ss, 16); ss += __shfl_xor(ss, 32);
    const float r = rsqrtf(ss * (1.0f / 192.0f) + RMS_EPS);
#pragma unroll
    for (int cp = 0; cp < 6; ++cp) {
        const int dv = 32 * cp + 8 * g4;
        const f32x4 g0 = *(const f32x4*)(gB + dv), g1 = *(const f32x4*)(gB + dv + 4);
        const u32x4 bw = *(const u32x4*)(proj + (size_t)t * PROJ_P + C_BR + h * 192 + dv);
        const float br[8] = {bflo(bw.x), bfhi(bw.x), bflo(bw.y), bfhi(bw.y), bflo(bw.z), bfhi(bw.z), bflo(bw.w), bfhi(bw.w)};
        f32x4 y0, y1;
#pragma unroll
        for (int i = 0; i < 4; ++i) { y0[i] = o[cp][0][i] * r * g0[i] * (br[i] / (1.0f + __expf(-br[i]))); y1[i] = o[cp][1][i] * r * g1[i] * (br[4 + i] / (1.0f + __expf(-br[4 + i]))); }
        *(u32x4*)(mixed + (size_t)t * 2048 + 768 + h * 192 + dv) = pack8(y0, y1);
    }
}
__device__ __forceinline__ void norm_ac_row(const bf16_t* __restrict__ Oa, const bf16_t* __restrict__ Oc, const float* __restrict__ gA, const float* __restrict__ gC, bf16_t* __restrict__ mixed, int t, int lane) {
    bf16_t* mrow = mixed + (size_t)t * 2048;
    const u32x2* pa = (const u32x2*)(Oa + (size_t)t * 768) + lane; const u32x2* pc = (const u32x2*)(Oc + (size_t)t * 512) + lane;
    f32x4 a[3], c[2]; float sa = 0.f, sc = 0.f;
#pragma unroll
    for (int i = 0; i < 3; ++i) { const u32x2 w = pa[64 * i]; a[i] = (f32x4){bflo(w.x), bfhi(w.x), bflo(w.y), bfhi(w.y)}; sa += (a[i][0] * a[i][0] + a[i][1] * a[i][1]) + (a[i][2] * a[i][2] + a[i][3] * a[i][3]); }
#pragma unroll
    for (int i = 0; i < 2; ++i) { const u32x2 w = pc[64 * i]; c[i] = (f32x4){bflo(w.x), bfhi(w.x), bflo(w.y), bfhi(w.y)}; sc += (c[i][0] * c[i][0] + c[i][1] * c[i][1]) + (c[i][2] * c[i][2] + c[i][3] * c[i][3]); }
    const float ra = rsqrtf(wave_sum(sa) * (1.0f / 768.0f) + RMS_EPS), rc = rsqrtf(wave_sum(sc) * (1.0f / 512.0f) + RMS_EPS);
#pragma unroll
    for (int i = 0; i < 3; ++i) { const f32x4 g = ((const f32x4*)gA)[lane + 64 * i]; const f32x4 y = a[i] * ra * g; ((u32x2*)mrow)[lane + 64 * i] = (u32x2){pk2(y[0], y[1]), pk2(y[2], y[3])}; }
#pragma unroll
    for (int i = 0; i < 2; ++i) { const f32x4 g = ((const f32x4*)gC)[lane + 64 * i]; const f32x4 y = c[i] * rc * g; ((u32x2*)(mrow + 1536))[lane + 64 * i] = (u32x2){pk2(y[0], y[1]), pk2(y[2], y[3])}; }
}


constexpr int SB2_QS = 0, SB2_KV = 18432, SB2_KVB = 18432, SB2_FL = SB2_KV + 2 * SB2_KVB;
__device__ __forceinline__ bf16x8 lds_frag_tr2(const LAS unsigned char* base, int stride, int ra, int rb, int c0, int pp, int lane) {
    const int i = lane & 15;
    const LAS unsigned char* p = base + (i >> 2) * stride + (c0 + 8 * (i & 3) + 4 * pp) * 2;
    const s16x4 lo = __builtin_bit_cast(s16x4, __builtin_amdgcn_ds_read_tr16_b64_v4i16((LAS s16x4*)(p + ra * stride)));
    const s16x4 hi = __builtin_bit_cast(s16x4, __builtin_amdgcn_ds_read_tr16_b64_v4i16((LAS s16x4*)(p + rb * stride)));
    return (bf16x8){lo[0], lo[1], lo[2], lo[3], hi[0], hi[1], hi[2], hi[3]};
}
template <bool DIAG> __device__ __forceinline__ void sb_step(const LAS unsigned char* KV, const bf16x8 qf0, const bf16x8 qf1, f32x4 (&oacc)[4], float& R, int s0, int t, int lane) {
    const int g4 = lane >> 4;
    constexpr float SC2 = 0.125f * 1.4426950408889634f;
    float zz[4][4], cc[4][4], T[4];
#pragma unroll
    for (int ct = 0; ct < 4; ++ct) {
        const bf16x8 k0 = lds_frag_row(KV, 144, 16 * ct, 0, lane), k1 = lds_frag_row(KV, 144, 16 * ct, 32, lane);
        f32x4 z = mfma16(k0, qf0, (f32x4){0.f, 0.f, 0.f, 0.f}); z = mfma16(k1, qf1, z);
        float run = 0.f;
#pragma unroll
        for (int i = 3; i >= 0; --i) {
            const float z2 = z[i] * SC2;
            float L = -(fmaxf(z2, 0.f) + __builtin_amdgcn_logf(1.0f + __builtin_amdgcn_exp2f(-fabsf(z2))));
            if (DIAG) { if (!(s0 + 16 * ct + 4 * g4 + i < t)) L = 0.f; }
            run += L; zz[ct][i] = z2; cc[ct][i] = run;
        }
        T[ct] = run;
    }
    float base[4], H = 0.f;
#pragma unroll
    for (int ct = 3; ct >= 0; --ct) {
        const float x1 = __shfl_xor(T[ct], 16), x2 = __shfl_xor(T[ct], 32), x3 = __shfl_xor(x1, 32);
        const float off = (((g4 ^ 1) > g4) ? x1 : 0.f) + (((g4 ^ 2) > g4) ? x2 : 0.f) + (((g4 ^ 3) > g4) ? x3 : 0.f);
        base[ct] = R + H + off;
        H += (T[ct] + x1) + (x2 + x3);
    }
    R += H;
    unsigned pw[4][2];
#pragma unroll
    for (int ct = 0; ct < 4; ++ct) {
        float w[4];
#pragma unroll
        for (int i = 0; i < 4; ++i) {
            w[i] = __builtin_amdgcn_exp2f(zz[ct][i] + cc[ct][i] + base[ct]);
            if (DIAG) { if (!(s0 + 16 * ct + 4 * g4 + i < t)) w[i] = 0.f; }
        }
        pw[ct][0] = pk2(w[0], w[1]); pw[ct][1] = pk2(w[2], w[3]);
    }
#pragma unroll
    for (int ks = 0; ks < 2; ++ks) {
        const u32x4 pu = (u32x4){pw[2 * ks][0], pw[2 * ks][1], pw[2 * ks + 1][0], pw[2 * ks + 1][1]};
        const bf16x8 pf = __builtin_bit_cast(bf16x8, pu);
#pragma unroll
        for (int d = 0; d < 4; ++d) {
            const bf16x8 vf = lds_frag_tr2(KV + 9216, 144, 32 * ks + 4 * g4, 32 * ks + 16 + 4 * g4, 32 * (d >> 1), d & 1, lane);
            oacc[d] = mfma16(vf, pf, oacc[d]);
        }
    }
}
__device__ __forceinline__ void sb_item2(LAS unsigned char* lds, const bf16_t* __restrict__ proj, bf16_t* __restrict__ Oc, int h, int qb, int tid) {
    const int lane = tid & 63, wave = __builtin_amdgcn_readfirstlane(tid >> 6), g4 = lane >> 4, l15 = lane & 15;
    const int q0 = 128 * qb;
#pragma unroll
    for (int i = 0; i < 2; ++i) {
        const int id = tid + NTHREADS * i, row = id >> 3, ch = id & 7;
        *(LAS u32x4*)(lds + SB2_QS + row * 144 + ch * 16) = *(const u32x4*)(proj + (size_t)(q0 + row) * PROJ_P + C_CQ + h * 64 + 8 * ch);
    }
    const int srow = tid >> 3, sch = tid & 7;
    const bf16_t* kvsrc = proj + (size_t)srow * PROJ_P + h * 64 + 8 * sch;
    u32x4 kreg = *(const u32x4*)(kvsrc + (size_t)(64 * (2 * qb + 1)) * PROJ_P + C_CK), vreg = *(const u32x4*)(kvsrc + (size_t)(64 * (2 * qb + 1)) * PROJ_P + C_CV);
    __syncthreads();
    const bf16x8 qf0 = lds_frag_row(lds + SB2_QS, 144, 16 * wave, 0, lane), qf1 = lds_frag_row(lds + SB2_QS, 144, 16 * wave, 32, lane);
    f32x4 oacc[4];
#pragma unroll
    for (int d = 0; d < 4; ++d) oacc[d] = (f32x4){0.f, 0.f, 0.f, 0.f};
    float R = 0.f;
    const int t = q0 + 16 * wave + l15;
    LAS int* FL = (LAS int*)(lds + SB2_FL);
    int bsel = 0;
    for (int kt = 2 * qb + 1; kt >= 0; --kt, bsel ^= 1) {
        LAS unsigned char* KV = lds + SB2_KV + bsel * SB2_KVB;
        *(LAS u32x4*)(KV + srow * 144 + sch * 16) = kreg;
        *(LAS u32x4*)(KV + 9216 + srow * 144 + sch * 16) = vreg;
        if (kt > 0) { kreg = *(const u32x4*)(kvsrc + (size_t)(64 * (kt - 1)) * PROJ_P + C_CK); vreg = *(const u32x4*)(kvsrc + (size_t)(64 * (kt - 1)) * PROJ_P + C_CV); }
        const int alld = __all(R < -152.0f);
        if (lane == 0) FL[bsel * 8 + wave] = alld;
        __syncthreads();
        bool done = true;
#pragma unroll
        for (int w = 0; w < 8; ++w) done = done && (FL[bsel * 8 + w] != 0);
        if (done) break;
        const int s0 = 64 * kt;
        if (s0 >= q0 + 16 * wave + 16) continue;
        if (kt >= 2 * qb) sb_step<true>(KV, qf0, qf1, oacc, R, s0, t, lane);
        else sb_step<false>(KV, qf0, qf1, oacc, R, s0, t, lane);
    }
#pragma unroll
    for (int dp = 0; dp < 2; ++dp) *(u32x4*)(Oc + (size_t)t * 512 + h * 64 + 32 * dp + 8 * g4) = pack8(oacc[2 * dp], oacc[2 * dp + 1]);
    __syncthreads();
}


constexpr int SW2_KS = 0, SW2_VS = 36864, SW2_BT = 76032;
template <bool N0> __device__ __forceinline__ void swa_head(const LAS unsigned char* lds, const bf16x8 qf0, const bf16x8 qf1, float sink2, int g, int wave, int lane, f32x4 (&o)[4], float& linv) {
    const int g4 = lane >> 4, l15 = lane & 15;
    constexpr float SC2 = 0.125f * 1.4426950408889634f;
    const LAS float* bt = (const LAS float*)(lds + SW2_BT) + g * 160 + (128 + 16 + l15 - 4 * g4);
    f32x4 st[9];
    float mt = -3.0e38f;
#pragma unroll
    for (int jt = 0; jt < 9; ++jt) {
        const bf16x8 k0 = lds_frag_row(lds + SW2_KS, 144, 16 * (wave + jt), 0, lane), k1 = lds_frag_row(lds + SW2_KS, 144, 16 * (wave + jt), 32, lane);
        f32x4 c = (f32x4){bt[-16 * jt], bt[-16 * jt - 1], bt[-16 * jt - 2], bt[-16 * jt - 3]};
        if (N0) {
#pragma unroll
            for (int i = 0; i < 4; ++i) if (16 * (wave + jt) + 4 * g4 + i < 128) c[i] = -1e30f;
        }
        c = mfma16(k0, qf0, c); c = mfma16(k1, qf1, c);
        st[jt] = c;
        mt = fmaxf(mt, fmaxf(fmaxf(c[0], c[1]), fmaxf(c[2], c[3])));
    }
    mt = fmaxf(mt, __shfl_xor(mt, 16)); mt = fmaxf(mt, __shfl_xor(mt, 32));
    const float m = fmaxf(mt * SC2, sink2);
    float l = 0.f;
    unsigned pw[10][2];
#pragma unroll
    for (int jt = 0; jt < 9; ++jt) {
        float e[4];
#pragma unroll
        for (int i = 0; i < 4; ++i) { e[i] = __builtin_amdgcn_exp2f(st[jt][i] * SC2 - m); l += e[i]; }
        pw[jt][0] = pk2(e[0], e[1]); pw[jt][1] = pk2(e[2], e[3]);
    }
    pw[9][0] = 0u; pw[9][1] = 0u;
    l += __shfl_xor(l, 16); l += __shfl_xor(l, 32);
    linv = 1.0f / (l + __builtin_amdgcn_exp2f(sink2 - m));
#pragma unroll
    for (int d = 0; d < 4; ++d) o[d] = (f32x4){0.f, 0.f, 0.f, 0.f};
#pragma unroll
    for (int c = 0; c < 5; ++c) {
        const u32x4 pu = (u32x4){pw[2 * c][0], pw[2 * c][1], pw[2 * c + 1][0], pw[2 * c + 1][1]};
        const bf16x8 pf = __builtin_bit_cast(bf16x8, pu);
        const int ra = 16 * (wave + 2 * c) + 4 * g4;
#pragma unroll
        for (int d = 0; d < 4; ++d) { const bf16x8 vf = lds_frag_tr2(lds + SW2_VS, 144, ra, ra + 16, 32 * (d >> 1), d & 1, lane); o[d] = mfma16(vf, pf, o[d]); }
    }
}
__device__ __forceinline__ void swa_item2(LAS unsigned char* lds, const bf16_t* __restrict__ proj, const float* __restrict__ sinks, const float* __restrict__ relb, bf16_t* __restrict__ Oa, int n, int hk, int tid) {
    const int lane = tid & 63, wave = __builtin_amdgcn_readfirstlane(tid >> 6), g4 = lane >> 4, l15 = lane & 15;
#pragma unroll
    for (int i = 0; i < 4; ++i) {
        const int id = tid + NTHREADS * i, row = id >> 3, ch = id & 7, s = 128 * (n - 1) + row;
        u32x4 kv = (u32x4){0u, 0u, 0u, 0u}, vv = (u32x4){0u, 0u, 0u, 0u};
        if (s >= 0) { const bf16_t* src = proj + (size_t)s * PROJ_P + hk * 64 + 8 * ch; kv = *(const u32x4*)(src + C_AK); vv = *(const u32x4*)(src + C_AV); }
        *(LAS u32x4*)(lds + SW2_KS + row * 144 + ch * 16) = kv;
        *(LAS u32x4*)(lds + SW2_VS + row * 144 + ch * 16) = vv;
    }
    if (tid < 128) { const int row = 256 + (tid >> 3), ch = tid & 7; *(LAS u32x4*)(lds + SW2_VS + row * 144 + ch * 16) = (u32x4){0u, 0u, 0u, 0u}; }
    if (tid < 480) { const int g = tid / 160, e = tid % 160, dist = e - 16; ((LAS float*)(lds + SW2_BT))[tid] = (dist >= 0 && dist < 128) ? 8.0f * relb[(int)T5B[dist] * 12 + 3 * hk + g] : -1e30f; }
    __syncthreads();
    const int t = 128 * n + 16 * wave + l15;
    for (int g = 0; g < 3; ++g) {
        const int hq = 3 * hk + g;
        const bf16_t* qrow = proj + (size_t)t * PROJ_P + C_AQ + hq * 64 + 8 * g4;
        const bf16x8 qf0 = *(const bf16x8*)qrow, qf1 = *(const bf16x8*)(qrow + 32);
        const float sink2 = sinks[hq] * 1.4426950408889634f;
        f32x4 o[4]; float linv;
        if (n == 0) swa_head<true>(lds, qf0, qf1, sink2, g, wave, lane, o, linv);
        else swa_head<false>(lds, qf0, qf1, sink2, g, wave, lane, o, linv);
#pragma unroll
        for (int dp = 0; dp < 2; ++dp) *(u32x4*)(Oa + (size_t)t * 768 + hq * 64 + 32 * dp + 8 * g4) = pack8(o[2 * dp] * linv, o[2 * dp + 1] * linv);
    }
    __syncthreads();
}

struct Params { const float* in[15]; float* out; unsigned char* ws; int ph_lo, ph_hi; };

constexpr int CV_STRIDE = 528, CV_BUF = 64 * CV_STRIDE;
constexpr int CV_NWIN = 32 * 21, CV_NOUT = 32 * 8, CV_N1 = 32 * 32, CV_N2 = 128 * 8, CV_NREST = CV_NOUT + CV_N1 + CV_N2;
constexpr int CV_DEFER = 96 * 12;
constexpr int CV_SHADOW = 0;
constexpr int CV_STG = 128 * 8;
constexpr int CV_NPL = CV_NREST - CV_DEFER - CV_STG;
constexpr int CV_NPRO = 2 * CV_NWIN + 2 * CV_NPL;
struct CvTile { const float* src; const float* gain; bf16_t* dst; int N, K, zero_from; };
__device__ __forceinline__ CvTile cv_win(const Params& p, int l, int r) {
    const int kb = r / 21, nt = r % 21;
    const int srccol = (nt < 14) ? 256 * nt : (nt < 20 ? 256 * nt + 16 : 3584);
    CvTile t; t.N = PROJ_W; t.K = DM; t.zero_from = (nt == 20) ? 16 : 256;
    t.src = p.in[2] + (size_t)l * DM * PROJ_W + (size_t)(64 * kb) * PROJ_W + srccol; t.gain = p.in[1] + l * DM + 64 * kb;
    t.dst = (bf16_t*)(p.ws + WS_WT + (size_t)l * WT_LAYER + WT_IN) + (size_t)(256 * nt) * DM + 64 * kb;
    return t;
}
__device__ __forceinline__ CvTile cv_rest(const Params& p, int l, int r) {
    CvTile t; t.zero_from = 256;
    if (r < CV_NOUT) { const int kb = r / 8, nt = r % 8; t.N = DM; t.K = DM; t.src = p.in[10] + (size_t)l * DM * DM + (size_t)(64 * kb) * DM + 256 * nt; t.gain = nullptr;
                       t.dst = (bf16_t*)(p.ws + WS_WT + (size_t)l * WT_LAYER + WT_OUT) + (size_t)(256 * nt) * DM + 64 * kb; return t; }
    r -= CV_NOUT;
    if (r < CV_N1) { const int kb = r / 32, nt = r % 32; t.N = DFF; t.K = DM; t.src = p.in[12] + (size_t)l * DM * DFF + (size_t)(64 * kb) * DFF + 256 * nt; t.gain = p.in[11] + l * DM + 64 * kb;
                     t.dst = (bf16_t*)(p.ws + WS_WT + (size_t)l * WT_LAYER + WT_1) + (size_t)(256 * nt) * DM + 64 * kb; return t; }
    r -= CV_N1;
    { const int kb = r / 8, nt = r % 8; t.N = DM; t.K = DFF; t.src = p.in[13] + (size_t)l * DFF * DM + (size_t)(64 * kb) * DM + 256 * nt; t.gain = nullptr;
      t.dst = (bf16_t*)(p.ws + WS_WT + (size_t)l * WT_LAYER + WT_2) + (size_t)(256 * nt) * DFF + 64 * kb; return t; }
}
__device__ __forceinline__ CvTile cv_make(const Params& p, int mode, int l, int idx) {
    if (mode == 1) return cv_rest(p, l, idx);
    if (mode == 3) return cv_rest(p, l, CV_NOUT + CV_N1 + idx);
    if (idx < CV_NWIN) return cv_win(p, 0, idx);
    if (idx < 2 * CV_NWIN) return cv_win(p, 1, idx - CV_NWIN);
    const int j = idx - 2 * CV_NWIN, ll = j / CV_NPL; int r = CV_DEFER + j % CV_NPL;
    if (r >= CV_NOUT + CV_N1) r += CV_STG;
    return cv_rest(p, ll, r);
}
__device__ __forceinline__ void cv_load(const CvTile& t, int wave, int lane, f32x4 (&v)[8]) {
#pragma unroll
    for (int j = 0; j < 8; ++j) {
        const int k = 8 * wave + j;
        f32x4 x = (f32x4){0.f, 0.f, 0.f, 0.f};
        if (4 * lane < t.zero_from) x = *(const f32x4*)(t.src + (size_t)k * t.N + 4 * lane);
        const float g = t.gain ? t.gain[k] : 1.0f;
        v[j] = x * g;
    }
}
__device__ __forceinline__ void cv_run(LAS unsigned char* lds, const Params& p, int mode, int l, int first, int stride, int count, int tid) {
    if (count <= 0) return;
    const int lane = tid & 63, wave = __builtin_amdgcn_readfirstlane(tid >> 6);
    CvTile cur = cv_make(p, mode, l, first);
    f32x4 v[8];
    cv_load(cur, wave, lane, v);
    for (int i = 0; i < count; ++i) {
        LAS unsigned char* buf = lds + (i & 1) * CV_BUF;
#pragma unroll
        for (int j = 0; j < 8; ++j) *(LAS u32x2*)(buf + (8 * wave + j) * CV_STRIDE + 8 * lane) = (u32x2){pk2(v[j][0], v[j][1]), pk2(v[j][2], v[j][3])};
        CvTile nxt = cur;
        if (i + 1 < count) { nxt = cv_make(p, mode, l, first + (i + 1) * stride); cv_load(nxt, wave, lane, v); }
        __syncthreads();
#pragma unroll
        for (int grp = 0; grp < 2; ++grp)
#pragma unroll
            for (int kh = 0; kh < 2; ++kh) {
                const int c0 = 32 * wave + 16 * grp;
                const bf16x8 f = lds_frag_tr(buf, CV_STRIDE, 32 * kh, c0, lane);
                *(bf16x8*)(cur.dst + (size_t)(c0 + (lane & 15)) * cur.K + 32 * kh + 8 * (lane >> 4)) = f;
            }
        cur = nxt;
    }
    __syncthreads();
}

#ifndef PH_MASK
#define PH_MASK 0x1ff
#endif
#define HAS(k) (((PH_MASK) >> (k)) & 1)
#define XB_TMO      128
#define XB_XCNT(j)  (256  + 64 * (j))
#define XB_XSUB(j)  (1280 + 64 * (j))
#define XB_XGEN(j)  (2304 + 64 * (j))
#define XB_TOP      3328
#define XB_TOPGEN   3392
#define XCD_BAR_WORDS 3456
#define XB_SPIN_CAP (1u << 18)

__device__ __forceinline__ unsigned xb_ld(unsigned* p)              { return __hip_atomic_load(p, __ATOMIC_RELAXED, __HIP_MEMORY_SCOPE_AGENT); }
__device__ __forceinline__ unsigned xb_add(unsigned* p, unsigned v) { return __hip_atomic_fetch_add(p, v, __ATOMIC_RELAXED, __HIP_MEMORY_SCOPE_AGENT); }
__device__ __forceinline__ unsigned xb_xcc_id() { return (unsigned)__builtin_amdgcn_s_getreg((3 << 11) | 20) & 0xFu; }
#define XB_SPIN(cond, bar) do { unsigned _sp = 0; while (cond) { __builtin_amdgcn_s_sleep(1); \
    if ((++_sp & 255u) == 0u) { if (xb_ld(&(bar)[XB_TMO])) break; if (_sp > XB_SPIN_CAP) { atomicAdd(&(bar)[XB_TMO], 1u); break; } } } } while (0)

struct XcdBarrier {
    unsigned* bar; unsigned x;
    volatile LAS unsigned* st;
};

__device__ __forceinline__ XcdBarrier xcd_barrier_post(unsigned* bar, volatile LAS unsigned* st) {
    XcdBarrier b; b.bar = bar; b.x = xb_xcc_id(); b.st = st;
    if (threadIdx.x == 0) (void)xb_add(&bar[XB_XCNT(b.x)], 1u);
    return b;
}
__device__ __forceinline__ void xcd_barrier_complete(unsigned* bar, unsigned x, unsigned& nloc, unsigned& nx) {
    const unsigned G = gridDim.x * gridDim.y * gridDim.z;
    unsigned sum, cnt, mine, sp = 0u;
    for (;;) {
        sum = 0u; cnt = 0u; mine = 0u;
#pragma unroll
        for (unsigned j = 0; j < 16; ++j) { const unsigned c = xb_ld(&bar[XB_XCNT(j)]); sum += c; cnt += (c > 0u) ? 1u : 0u; mine = (j == x) ? c : mine; }
        if (sum == G) break;
        __builtin_amdgcn_s_sleep(1);
        if ((++sp & 255u) == 0u) { if (xb_ld(&bar[XB_TMO])) break; if (sp > XB_SPIN_CAP) { atomicAdd(&bar[XB_TMO], 1u); break; } }
    }
    nloc = mine > 0u ? mine : 1u; nx = cnt > 0u ? cnt : 1u;
}

__device__ __forceinline__ void xcd_barrier(const XcdBarrier& b) {
    asm volatile("s_waitcnt vmcnt(0)" ::: "memory");
    __syncthreads();
    if (threadIdx.x == 0) {
        unsigned* bar = b.bar;
        __builtin_amdgcn_s_waitcnt(0);
        unsigned nloc = b.st[0], nx = b.st[1];
        if (nloc == 0u) { xcd_barrier_complete(bar, b.x, nloc, nx); b.st[0] = nloc; b.st[1] = nx; }
        const unsigned old = xb_add(&bar[XB_XSUB(b.x)], 1u);
        const unsigned gen = old / nloc;
        if (old + 1u == (gen + 1u) * nloc) {
            __builtin_amdgcn_fence(__ATOMIC_RELEASE, "agent");
            asm volatile("s_waitcnt vmcnt(0)" ::: "memory");
            const unsigned og = xb_add(&bar[XB_TOP], 1u);
            const unsigned tg = og / nx;
            if (og + 1u == (tg + 1u) * nx) xb_add(&bar[XB_TOPGEN], 1u);
            else XB_SPIN(xb_ld(&bar[XB_TOPGEN]) == tg, bar);
            __builtin_amdgcn_fence(__ATOMIC_ACQUIRE, "agent");
            xb_add(&bar[XB_XGEN(b.x)], 1u);
            asm volatile("s_waitcnt vmcnt(0)" ::: "memory");
        } else {
            XB_SPIN(xb_ld(&bar[XB_XGEN(b.x)]) == gen, bar);
            __builtin_amdgcn_fence(__ATOMIC_ACQUIRE, "agent");
            asm volatile("s_waitcnt vmcnt(0)" ::: "memory");
        }
    }
    __syncthreads();
}

#define SB_XSUB(j) (4096 + 64 * (j))
#define SB_TOP     (4096 + 64 * 16)
#define SB_XGEN(j) (4096 + 64 * 17 + 64 * (j))
__device__ __forceinline__ void split_arrive(const XcdBarrier& b) {
    asm volatile("s_waitcnt vmcnt(0)" ::: "memory");
    __syncthreads();
    if (threadIdx.x == 0) {
        unsigned* bar = b.bar;
        const unsigned nloc = b.st[0], nx = b.st[1];
        const unsigned old = xb_add(&bar[SB_XSUB(b.x)], 1u);
        if ((old + 1u) % nloc == 0u) {
            __builtin_amdgcn_fence(__ATOMIC_RELEASE, "agent");
            asm volatile("s_waitcnt vmcnt(0)" ::: "memory");
            const unsigned og = xb_add(&bar[SB_TOP], 1u);
            if ((og + 1u) % nx == 0u) {
#pragma unroll
                for (unsigned j = 0; j < 16; ++j) if (xb_ld(&bar[XB_XCNT(j)]) > 0u) xb_add(&bar[SB_XGEN(j)], 1u);
            }
        }
    }
}
__device__ __forceinline__ void split_wait(const XcdBarrier& b, unsigned epoch) {
    if (threadIdx.x == 0) {
        unsigned* bar = b.bar;
        XB_SPIN(xb_ld(&bar[SB_XGEN(b.x)]) < epoch, bar);
        __builtin_amdgcn_fence(__ATOMIC_ACQUIRE, "agent");
        asm volatile("s_waitcnt vmcnt(0)" ::: "memory");
    }
    __syncthreads();
}

#ifdef PROBE_CAT
#define PROBE_DECL unsigned long long pr_last = __builtin_amdgcn_s_memrealtime(), pr_acc = 0
#define STAMP(cat) do { const unsigned long long now_ = __builtin_amdgcn_s_memrealtime(); if ((cat) == PROBE_CAT) pr_acc += now_ - pr_last; pr_last = now_; } while (0)
#else
#define PROBE_DECL do {} while (0)
#define STAMP(cat) do {} while (0)
#endif
constexpr int N_PHASES = 16;

__global__ void __launch_bounds__(NTHREADS, 2) mega(Params p) {
    extern __shared__ __attribute__((aligned(16))) unsigned char lds_raw[];
    LAS unsigned char* lds = (LAS unsigned char*)lds_raw;
    volatile LAS unsigned* bst = (volatile LAS unsigned*)(lds + LDS_BYTES - 16);
    if (threadIdx.x == 0) { bst[0] = 0u; bst[1] = 0u; }
    __syncthreads();
    const XcdBarrier bar = xcd_barrier_post((unsigned*)(p.ws + WS_CTL) + 1024, bst);
    const int G = gridDim.x;
    PROBE_DECL;
    unsigned char* ws = p.ws;
    const float* x_in = p.in[0];
    float* xres = p.out;
    bf16_t* xb = (bf16_t*)(ws + WS_XB);
    float* rowss = (float*)(ws + WS_ROWSS);
    bf16_t* proj = (bf16_t*)(ws + WS_PROJ);
    bf16_t* Oa = (bf16_t*)(ws + WS_OA); bf16_t* Ob = (bf16_t*)(ws + WS_OB); bf16_t* Oc = (bf16_t*)(ws + WS_OC);
    float* dstate = (float*)(ws + WS_DSTATE); float* decay = (float*)(ws + WS_DECAY); bf16_t* sprev = (bf16_t*)(ws + WS_SPREV); bf16_t* qdec = (bf16_t*)(ws + WS_QDEC);
    bf16_t* mixed = (bf16_t*)(ws + WS_MIXED);
    bf16_t* hid = (bf16_t*)(ws + WS_HID);
#define IN(k) (p.ph_lo <= (k) && (k) < p.ph_hi)
#define SYNC(k) do { if (IN(k) && IN((k) + 1)) xcd_barrier(bar); STAMP(1); } while (0)
#define PHASE_IDS() int tid = threadIdx.x; asm volatile("" : "+v"(tid)); const int lane = tid & 63, wave = __builtin_amdgcn_readfirstlane(tid >> 6), gw = blockIdx.x * NWAVES + wave, NGW = G * NWAVES; (void)lane; (void)gw; (void)NGW

    if (HAS(0) && IN(0)) {
        PHASE_IDS();
        {
            const int first = blockIdx.x, cnt = (first < CV_NPRO) ? (CV_NPRO - first + G - 1) / G : 0;
            cv_run(lds, p, 0, 0, first, G, cnt, tid);
        }
        if (G != 256) { for (int ll = 0; ll < DEPTH; ++ll) { const int f2 = blockIdx.x, c2 = (f2 < CV_DEFER) ? (CV_DEFER - f2 + G - 1) / G : 0, c3 = (f2 < CV_STG) ? (CV_STG - f2 + G - 1) / G : 0; cv_run(lds, p, 1, ll, f2, G, c2, tid); cv_run(lds, p, 3, ll, f2, G, c3, tid); } }
        for (int m = gw; m < SEQ; m += NGW) {
            const f32x4* xr = (const f32x4*)(x_in + (size_t)m * DM) + lane;
            f32x4 v[8]; float ss = 0.f;
#pragma unroll
            for (int j = 0; j < 8; ++j) { v[j] = xr[64 * j]; ss += (v[j][0] * v[j][0] + v[j][1] * v[j][1]) + (v[j][2] * v[j][2] + v[j][3] * v[j][3]); }
            ss = wave_sum(ss);
            u32x2* o8 = (u32x2*)(xb + (size_t)m * DM) + lane;
#pragma unroll
            for (int j = 0; j < 8; ++j) { u32x2 w; w.x = pk2(v[j][0], v[j][1]); w.y = pk2(v[j][2], v[j][3]); o8[64 * j] = w; }
            if (lane < 32) rowss[(size_t)m * 32 + lane] = (lane == 0) ? ss : 0.f;
        }
    }
    STAMP(0);
    SYNC(0);
    for (int l = 0; l < DEPTH; ++l) {
        const int pb = 1 + 7 * l;
        unsigned char* wt = ws + WS_WT + (size_t)l * WT_LAYER;
        if (HAS(1) && IN(pb + 0)) {
            pg8::Gemm g{xb, (const bf16_t*)(wt + WT_IN), SEQ, PROJ_P, DM}; pg8::StaticOrder S; S.init(SEQ, PROJ_P, G, (int)blockIdx.x);
            pg8::EpiScale<0> E{proj, PROJ_P, rowss};
            const bool light = (G == 256 && blockIdx.x >= 160);
#pragma unroll 1
            for (int part = 0; part < 2; ++part) {
                if (light) {
                    int tid2 = threadIdx.x; asm volatile("" : "+v"(tid2));
                    cv_run(lds, p, 1, l, (int)blockIdx.x - 160 + part * (CV_DEFER / 2), 96, CV_DEFER / 192, tid2);
                }
                if (part == 0) pg8::gemm_phase<pg8::EpiScale<0>, pg8::StaticOrder, true, true>(lds, g, S, E);
            }
        }
        STAMP(2);
        SYNC(pb + 0);
        if (HAS(2) && IN(pb + 1)) {
            PHASE_IDS();
            const float* gwt = p.in[5] + (size_t)l * 16 * 384; const float* gbs = p.in[6] + l * 384;
            for (int it = blockIdx.x; it < 512; it += G) gla_local_item(lds, proj, gwt, gbs, Ob, dstate, decay, qdec, it >> 2, it & 3, tid);
            STAMP(10);
            split_arrive(bar);
            const float* sinks = p.in[3] + l * 12; const float* relb = p.in[4];
            for (int it = blockIdx.x; it < 256; it += G) swa_item2(lds, proj, sinks, relb, Oa, it >> 2, it & 3, tid);
            STAMP(11);
            for (int it = blockIdx.x; it < 512; it += G) sb_item2(lds, proj, Oc, it & 7, it >> 3, tid);
            STAMP(12);
            split_wait(bar, 2u * (unsigned)l + 1u);
            STAMP(13);
            {
                const int per = (73728 + G - 1) / G, e1 = min((int)(blockIdx.x + 1) * per, 73728);
                for (int e = blockIdx.x * per + tid; e < e1; e += NTHREADS) gla_scan_elem(dstate, decay, sprev, e);
            }
            STAMP(4);
            split_arrive(bar);
            cv_run(lds, p, 2, l, (int)blockIdx.x, G, CV_SHADOW / 256, tid);
            STAMP(14);
            split_wait(bar, 2u * (unsigned)l + 2u);
            STAMP(15);
            const float* gA = p.in[8] + l * 768; const float* gB = p.in[7] + l * 192; const float* gC = p.in[9] + l * 512;
            for (int it = gw; it < 2048; it += NGW) gla_out_task(proj, qdec, sprev, Ob, gB, mixed, it >> 4, (it >> 2) & 3, it & 3, lane);
            for (int t = gw; t < SEQ; t += NGW) norm_ac_row(Oa, Oc, gA, gC, mixed, t, lane);
            STAMP(5);
        }
        SYNC(pb + 1);
        if (HAS(5) && IN(pb + 4)) {
            pg8::Gemm g{mixed, (const bf16_t*)(wt + WT_OUT), SEQ, DM, DM}; pg8::StaticOrder S; S.init(SEQ, DM, G, (int)blockIdx.x);
            pg8::EpiResid E{xb, rowss};
            pg8::gemm_phase<pg8::EpiResid, pg8::StaticOrder, true, true>(lds, g, S, E);
        }
        STAMP(6);
        SYNC(pb + 4);
        if (HAS(6) && IN(pb + 5)) {
            pg8::Gemm g{xb, (const bf16_t*)(wt + WT_1), SEQ, DFF, DM}; pg8::StaticOrder S; S.init(SEQ, DFF, G, (int)blockIdx.x);
            pg8::EpiScale<1> E{hid, DFF, rowss};
            if (G == 256 && ((blockIdx.x >> 3) & 1)) {
                int tid2 = threadIdx.x; asm volatile("" : "+v"(tid2));
                const int e = (int)(((blockIdx.x >> 4) << 3) | (blockIdx.x & 7));
                cv_run(lds, p, 3, l, e, 128, CV_STG / 128, tid2);
            }
            pg8::gemm_phase<pg8::EpiScale<1>, pg8::StaticOrder, true, true>(lds, g, S, E);
        }
        STAMP(7);
        SYNC(pb + 5);
        if (HAS(7) && IN(pb + 6)) {
            pg8::Gemm g{hid, (const bf16_t*)(wt + WT_2), SEQ, DM, DFF}; pg8::StaticOrder S; S.init(SEQ, DM, G, (int)blockIdx.x);
            pg8::EpiResid E{xb, rowss};
            pg8::gemm_phase<pg8::EpiResid, pg8::StaticOrder, true, true>(lds, g, S, E);
        }
        STAMP(8);
        SYNC(pb + 6);
    }
    if (HAS(8) && IN(N_PHASES - 1)) {
        PHASE_IDS();
        const float* gF = p.in[14];
        for (int m = gw; m < SEQ; m += NGW) {
            const float part = (lane < 32) ? rowss[(size_t)m * 32 + lane] : 0.f;
            const float rstd = rsqrtf(wave_sum(part) * (1.0f / 2048.0f) + RMS_EPS);
            const u32x2* xr = (const u32x2*)(xb + (size_t)m * DM) + lane;
            f32x4* orow = (f32x4*)(xres + (size_t)m * DM) + lane;
            const f32x4* gr = (const f32x4*)gF + lane;
#pragma unroll
            for (int j = 0; j < 8; ++j) { const u32x2 w = xr[64 * j]; const f32x4 g = gr[64 * j]; f32x4 v = (f32x4){bflo(w.x), bfhi(w.x), bflo(w.y), bfhi(w.y)}; v = v * rstd * g; orow[64 * j] = v; }
        }
    }
#ifdef PROBE_CAT
    STAMP(9);
    if (blockIdx.x == 0) { const unsigned long long t0_ = __builtin_amdgcn_s_memrealtime(); while (__builtin_amdgcn_s_memrealtime() - t0_ < 4ull * pr_acc) __builtin_amdgcn_s_sleep(8); }
#endif
}

#ifndef MK_N_LAUNCHES
#define MK_N_LAUNCHES 1
#endif
extern "C" void kernel_launch(void* const* d_in, const int* in_sizes, int n_in, void* d_out, int out_size, void* d_ws, size_t ws_size, hipStream_t stream) {
    static int grid = 0;
    if (grid == 0) {
        if (n_in != 15 || out_size != SEQ * DM || ws_size < WS_END) { fprintf(stderr, "kernel_launch: unexpected shapes (n_in %d out %d ws %zu)\n", n_in, out_size, ws_size); grid = -1; return; }
        int dev = 0, cus = 0, per_cu = 0;
        hipGetDevice(&dev);
        hipDeviceGetAttribute(&cus, hipDeviceAttributeMultiprocessorCount, dev);
        hipFuncSetAttribute((const void*)mega, hipFuncAttributeMaxDynamicSharedMemorySize, LDS_BYTES);
        hipOccupancyMaxActiveBlocksPerMultiprocessor(&per_cu, (const void*)mega, NTHREADS, LDS_BYTES);
        if (per_cu < 1) { fprintf(stderr, "kernel_launch: the occupancy query admits %d workgroups per CU for this kernel; nothing launched\n", per_cu); (void)hipGetLastError(); grid = -1; return; }
        (void)hipGetLastError();
        grid = cus * 1;
    }
    if (grid < 0) return;
    if (hipMemsetAsync((char*)d_ws + WS_CTL, 0, 65536, stream) != hipSuccess) { fprintf(stderr, "kernel_launch: memset failed\n"); return; }
    Params p{};
    for (int i = 0; i < 15; ++i) p.in[i] = (const float*)d_in[i];
    p.out = (float*)d_out; p.ws = (unsigned char*)d_ws;
    if (MK_N_LAUNCHES == 1) {
        p.ph_lo = 0; p.ph_hi = N_PHASES;
        void* args[] = {&p};
        hipError_t e = hipLaunchCooperativeKernel((const void*)mega, dim3(grid), dim3(NTHREADS), args, LDS_BYTES, stream);
        if (e != hipSuccess) fprintf(stderr, "cooperative launch failed: %s (grid %d)\n", hipGetErrorString(e), grid);
    } else {
        for (int ph = 0; ph < N_PHASES; ++ph) {
            p.ph_lo = ph; p.ph_hi = ph + 1;
            hipLaunchKernelGGL(mega, dim3(grid), dim3(NTHREADS), LDS_BYTES, stream, p);
        }
    }
}
```

```cpp
#include <hip/hip_runtime.h>
#include <hip/hip_cooperative_groups.h>
#include <cstdio>
#include <cstdint>
namespace cg = cooperative_groups;
namespace pg8 {
#define PG8_LAS __attribute__((address_space(3)))
typedef unsigned short bf16_t;
typedef short bf16x8 __attribute__((ext_vector_type(8)));
typedef float f32x4 __attribute__((ext_vector_type(4)));
typedef unsigned u32x4 __attribute__((ext_vector_type(4)));
constexpr int BM = 256, BK = 64, HALF = 128, HTB = HALF * BK * 2  , STAGE_BYTES = 8 * HTB, NXCD = 8, WGM = 8;

__host__ __device__ __forceinline__ int lds_byte(int r, int c) { const int st = (r >> 4) * 2 + (c >> 5), rr = r & 15, cc = c & 31, ob = rr * 64 + cc * 2; return st * 1024 + (ob ^ (((ob >> 9) & 1) << 5)); }
__host__ __device__ __forceinline__ void stage_rc(int b, int& R, int& C) { const int st = b / 1024, sb = b % 1024, swz = sb ^ (((sb >> 9) & 1) << 5); R = (st >> 1) * 16 + swz / 64; C = (st & 1) * 32 + (swz % 64) / 2; }
__host__ __device__ __forceinline__ int perm32(int rho) { const int n = rho >> 4, i = rho & 15; return 8 * (i >> 2) + 4 * n + (i & 3); }

struct Unit { int pm, pn; };
struct Gemm { const bf16_t* A; const bf16_t* Bt; int M, N, K; };

struct StaticOrder {
    int nM, nN, nwg, G, c;
    __host__ __device__ void init(int M, int N, int G_, int c_) { nM = M / BM; nN = N / BM; nwg = nM * nN; G = G_; c = c_; }
    __host__ __device__ bool next(int i, Unit& u) const {
        const long L = (long)i * G + c; if (L >= nwg) return false;
        int wgid = (int)L; { const int q = nwg / NXCD, r = nwg % NXCD, xcd = wgid % NXCD, off = wgid / NXCD; wgid = (xcd < r ? xcd * (q + 1) : r * (q + 1) + (xcd - r) * q) + off; }
        const int nig = WGM * nN, gid = wgid / nig, fm = gid * WGM, gsz = (nM - fm) < WGM ? (nM - fm) : WGM;
        u.pm = fm + ((wgid % nig) % gsz); u.pn = (wgid % nig) / gsz; return true;
    }
    __device__ __forceinline__ void a_ready(const Unit&) const {}
    __device__ __forceinline__ void done(const Unit&) const {}
};
__device__ __forceinline__ unsigned cvt_pk_bf16(float lo, float hi) { unsigned r; asm volatile("v_cvt_pk_bf16_f32 %0, %1, %2" : "=v"(r) : "v"(lo), "v"(hi)); return r; }
typedef float f32x2 __attribute__((ext_vector_type(2)));
template <class Epi, class Sched, bool ALIGN_EPI = false, bool SP2 = false>
__device__ __forceinline__ void gemm_phase(PG8_LAS unsigned char* lds, const Gemm g, const Sched& S, const Epi& E) {
    int tid_ = threadIdx.x; asm volatile("" : "+v"(tid_));
    const int tid = tid_, wid = __builtin_amdgcn_readfirstlane(tid >> 6), lane = tid & 63, wr = wid >> 2, wc = wid & 3, fr = lane & 15, fq = lane >> 4;
    const int K = g.K, nt = K / BK;
    unsigned voffA[2], voffB[2];
#pragma unroll
    for (int i = 0; i < 2; ++i) { int R, C; stage_rc(tid * 16 + i * 8192, R, C); const int Rb = Epi::PERM ? ((R & ~31) + perm32(R & 31)) : R;
        voffA[i] = (unsigned)(R * K + C) * 2u; voffB[i] = (unsigned)(Rb * K + C) * 2u; }
    const size_t kstep = (size_t)(BK * 2);
    const size_t hstep = (size_t)HALF * K * 2;
    const size_t tstep = 2 * hstep;
    const unsigned ldsw = (unsigned)wid * 1024u;
    const int aoff = lds_byte(wr * 64 + fr, fq * 8), boff = lds_byte(wc * 32 + fr, fq * 8);
#define PG8_SA(b, h) (((b) * 2 + (h)) * HTB)
#define PG8_SB(b, h) ((4 + (b) * 2 + (h)) * HTB)
#define PG8_STAGE(bufoff, gbase, voff) do { _Pragma("unroll") for (int _i = 0; _i < 2; ++_i) \
        __builtin_amdgcn_global_load_lds((const unsigned*)((const char*)(gbase) + (voff)[_i]), (PG8_LAS unsigned*)(lds + (bufoff) + ldsw + _i * 8192), 16, 0, 0); } while (0)
#define PG8_LDA(dst, b, h) do { _Pragma("unroll") for (int m = 0; m < 4; ++m) _Pragma("unroll") for (int k = 0; k < 2; ++k) dst[m][k] = *(const PG8_LAS bf16x8*)(lds + PG8_SA(b, h) + aoff + m * 2048 + k * 1024); } while (0)
#define PG8_LDB(dst, b, h) do { _Pragma("unroll") for (int n = 0; n < 2; ++n) _Pragma("unroll") for (int k = 0; k < 2; ++k) dst[n][k] = *(const PG8_LAS bf16x8*)(lds + PG8_SB(b, h) + boff + n * 2048 + k * 1024); } while (0)
#define PG8_MMA(ai, bj, At, Bt) do { __builtin_amdgcn_s_setprio(1); _Pragma("unroll") for (int m = 0; m < 4; ++m) _Pragma("unroll") for (int n = 0; n < 2; ++n) _Pragma("unroll") for (int k = 0; k < 2; ++k) \
        acc[ai][bj][m][n] = __builtin_amdgcn_mfma_f32_16x16x32_bf16(Bt[n][k], At[m][k], acc[ai][bj][m][n], 0, 0, 0); __builtin_amdgcn_s_setprio(0); } while (0)
#define PG8_WAIT_V(n) asm volatile("s_waitcnt vmcnt(" #n ")" ::: "memory")
#define PG8_WAIT_L(n) asm volatile("s_waitcnt lgkmcnt(" #n ")" ::: "memory")
#define PG8_BAR __builtin_amdgcn_s_barrier()
#define PG8_SCHED __builtin_amdgcn_sched_barrier(0)
    Unit cur, nxt; int ui = 0;
    if (!S.next(0, cur)) return;
    f32x4 acc[2][2][4][2];
#pragma unroll
    for (int a = 0; a < 2; ++a)
#pragma unroll
        for (int b = 0; b < 2; ++b)
#pragma unroll
            for (int m = 0; m < 4; ++m)
#pragma unroll
                for (int n = 0; n < 2; ++n) acc[a][b][m][n] = (f32x4){0.f, 0.f, 0.f, 0.f};
    bf16x8 At[4][2], B0[2][2], B1[2][2];
    const char* cA = (const char*)g.A + (size_t)cur.pm * tstep; const char* cB = (const char*)g.Bt + (size_t)cur.pn * tstep;
    S.a_ready(cur);
    if constexpr (SP2) {
        PG8_STAGE(PG8_SB(0, 0), cB, voffB); PG8_STAGE(PG8_SB(0, 1), cB + hstep, voffB); PG8_STAGE(PG8_SA(0, 0), cA, voffA); PG8_STAGE(PG8_SA(0, 1), cA + hstep, voffA);
        if (wr == 1) PG8_BAR;
        PG8_WAIT_V(2); PG8_BAR;
        PG8_STAGE(PG8_SB(1, 0), cB + kstep, voffB); PG8_STAGE(PG8_SA(1, 0), cA + kstep, voffA); PG8_STAGE(PG8_SB(1, 1), cB + hstep + kstep, voffB);
        PG8_WAIT_V(6); PG8_BAR;
    } else {
        PG8_STAGE(PG8_SB(0, 0), cB, voffB); PG8_STAGE(PG8_SA(0, 0), cA, voffA); PG8_STAGE(PG8_SB(0, 1), cB + hstep, voffB); PG8_STAGE(PG8_SA(0, 1), cA + hstep, voffA);
        if (wr == 1) PG8_BAR;
        PG8_WAIT_V(4); PG8_BAR;
        PG8_STAGE(PG8_SB(1, 0), cB + kstep, voffB); PG8_STAGE(PG8_SA(1, 0), cA + kstep, voffA); PG8_STAGE(PG8_SB(1, 1), cB + hstep + kstep, voffB);
        PG8_WAIT_V(6); PG8_BAR;
    }
    for (;;) {
        const bool has_next = S.next(ui + 1, nxt);
        const char* nA = has_next ? (const char*)g.A + (size_t)nxt.pm * tstep : cA; const char* nB = has_next ? (const char*)g.Bt + (size_t)nxt.pn * tstep : cB;
        for (int t = 0; t < nt; t += 2) {
            const bool last = (t == nt - 2);
            const char* a1 = cA + (size_t)(t + 1) * kstep;
            const char* a2 = last ? nA : cA + (size_t)(t + 2) * kstep; const char* b2 = last ? nB : cB + (size_t)(t + 2) * kstep;
            const char* a3 = a2 + kstep; const char* b3 = b2 + kstep;
            if (last && has_next) S.a_ready(nxt);
            if constexpr (SP2) {
            PG8_LDB(B0, 0, 0); PG8_LDB(B1, 0, 1); PG8_SCHED; PG8_LDA(At, 0, 0); PG8_STAGE(PG8_SA(1, 1), a1 + hstep, voffA);
            PG8_WAIT_V(8); PG8_WAIT_L(0); PG8_BAR; PG8_MMA(0, 0, At, B0); PG8_MMA(0, 1, At, B1); PG8_BAR; PG8_SCHED;
            PG8_LDA(At, 0, 1); PG8_STAGE(PG8_SB(0, 0), b2, voffB); PG8_STAGE(PG8_SB(0, 1), b2 + hstep, voffB); PG8_STAGE(PG8_SA(0, 0), a2, voffA);
            PG8_WAIT_V(8); PG8_WAIT_L(0); PG8_BAR; PG8_MMA(1, 0, At, B0); PG8_MMA(1, 1, At, B1); PG8_BAR; PG8_SCHED;
            PG8_LDB(B0, 1, 0); PG8_LDB(B1, 1, 1); PG8_SCHED; PG8_LDA(At, 1, 0); PG8_STAGE(PG8_SA(0, 1), a2 + hstep, voffA);
            PG8_WAIT_V(8); PG8_WAIT_L(0); PG8_BAR; PG8_MMA(0, 0, At, B0); PG8_MMA(0, 1, At, B1); PG8_BAR; PG8_SCHED;
            PG8_LDA(At, 1, 1); PG8_STAGE(PG8_SB(1, 0), b3, voffB); PG8_STAGE(PG8_SB(1, 1), b3 + hstep, voffB); PG8_STAGE(PG8_SA(1, 0), a3, voffA);
            PG8_WAIT_V(8); PG8_WAIT_L(0); PG8_BAR; PG8_MMA(1, 0, At, B0); PG8_MMA(1, 1, At, B1); PG8_BAR; PG8_SCHED;
            } else {
            PG8_LDB(B0, 0, 0); PG8_SCHED; PG8_LDA(At, 0, 0); PG8_STAGE(PG8_SA(1, 1), a1 + hstep, voffA);
            PG8_WAIT_L(8); PG8_BAR; PG8_WAIT_L(0); PG8_MMA(0, 0, At, B0); PG8_BAR; PG8_SCHED;
            PG8_LDB(B1, 0, 1); PG8_STAGE(PG8_SB(0, 0), b2, voffB);
            PG8_BAR; PG8_WAIT_L(0); PG8_MMA(0, 1, At, B1); PG8_BAR;
            PG8_LDA(At, 0, 1); PG8_STAGE(PG8_SA(0, 0), a2, voffA);
            PG8_BAR; PG8_WAIT_L(0); PG8_MMA(1, 0, At, B0); PG8_BAR; PG8_SCHED;
            PG8_STAGE(PG8_SB(0, 1), b2 + hstep, voffB);
            PG8_WAIT_V(6); PG8_BAR; PG8_MMA(1, 1, At, B1); PG8_BAR;
            PG8_LDB(B0, 1, 0); PG8_SCHED; PG8_LDA(At, 1, 0); PG8_STAGE(PG8_SA(0, 1), a2 + hstep, voffA);
            PG8_WAIT_L(8); PG8_BAR; PG8_WAIT_L(0); PG8_MMA(0, 0, At, B0); PG8_BAR; PG8_SCHED;
            PG8_LDB(B1, 1, 1); PG8_STAGE(PG8_SB(1, 0), b3, voffB);
            PG8_BAR; PG8_WAIT_L(0); PG8_MMA(0, 1, At, B1); PG8_BAR;
            PG8_LDA(At, 1, 1); PG8_STAGE(PG8_SA(1, 0), a3, voffA);
            PG8_BAR; PG8_WAIT_L(0); PG8_MMA(1, 0, At, B0); PG8_BAR; PG8_SCHED;
            PG8_STAGE(PG8_SB(1, 1), b3 + hstep, voffB);
            PG8_WAIT_V(6); PG8_BAR; PG8_MMA(1, 1, At, B1); PG8_BAR;
            }
        }
        if constexpr (ALIGN_EPI) { if (wr == 0) PG8_BAR; }
        if constexpr (!Epi::AFTER_DRAIN) { E(acc, cur, wr, wc, fr, fq); S.done(cur); }
        if (!has_next) break;
#pragma unroll
        for (int a = 0; a < 2; ++a)
#pragma unroll
            for (int b = 0; b < 2; ++b)
#pragma unroll
                for (int m = 0; m < 4; ++m)
#pragma unroll
                    for (int n = 0; n < 2; ++n) acc[a][b][m][n] = (f32x4){0.f, 0.f, 0.f, 0.f};
        cur = nxt; cA = nA; cB = nB; ++ui;
        if constexpr (ALIGN_EPI) { if (wr == 1) PG8_BAR; }
    }
    PG8_WAIT_V(0);
    if constexpr (!ALIGN_EPI) { if (wr == 0) PG8_BAR; }
    PG8_BAR;
    if constexpr (Epi::AFTER_DRAIN) { E.fused(acc, cur, wr, wc, fr, fq, lds, wid, lane); S.done(cur); }
#undef PG8_SA
#undef PG8_SB
#undef PG8_STAGE
#undef PG8_LDA
#undef PG8_LDB
#undef PG8_MMA
#undef PG8_WAIT_V
#undef PG8_WAIT_L
#undef PG8_BAR
#undef PG8_SCHED
}
}

#define LAS __attribute__((address_space(3)))
typedef unsigned short bf16_t;
typedef float f32x4 __attribute__((ext_vector_type(4)));
typedef unsigned u32x4 __attribute__((ext_vector_type(4)));
typedef unsigned u32x2 __attribute__((ext_vector_type(2)));
constexpr int SEQ = 8192, DM = 2048, DEPTH = 2, DFF = 8192;
constexpr int PROJ_W = 5136, PROJ_P = 5376;
constexpr int C_AQ = 0, C_AK = 768, C_AV = 1024, C_BQ = 1280, C_BK = 1664, C_BV = 2048, C_BR = 2816, C_CQ = 3584, C_CK = 4096, C_CV = 4608, C_LR = 5120;
constexpr float RMS_EPS = 1e-6f;
constexpr int NWAVES = 8, NTHREADS = 512;
constexpr int LDS_BYTES = 147456;

constexpr size_t MiB = 1u << 20;
constexpr size_t WS_CTL = 0;
constexpr size_t WS_ROWSS = 1 * MiB;
constexpr size_t WS_DECAY = 3 * MiB;
constexpr size_t WS_WT = 4 * MiB;
constexpr size_t WT_IN = 0, WT_OUT = 21 * MiB, WT_1 = 29 * MiB, WT_2 = 61 * MiB, WT_LAYER = 93 * MiB;
constexpr size_t WS_XB = 190 * MiB;
constexpr size_t WS_PROJ = 222 * MiB;
constexpr size_t WS_OA = 306 * MiB;
constexpr size_t WS_OC = 330 * MiB;
constexpr size_t WS_OB = 346 * MiB;
constexpr size_t WS_DSTATE = 370 * MiB;
constexpr size_t WS_SPREV = 406 * MiB;
constexpr size_t WS_QDEC = 424 * MiB;
constexpr size_t WS_MIXED = 430 * MiB;
constexpr size_t WS_HID = 222 * MiB;
constexpr size_t WS_END = 462 * MiB;

__device__ const unsigned char T5B[128] = {0, 1, 2, 3, 4, 5, 6, 7, 8, 9, 10, 11, 12, 13, 14, 15, 16, 16, 16, 17, 17, 18, 18, 18, 19, 19, 19, 20, 20, 20, 20, 21, 21, 21, 21, 22, 22, 22, 22, 22, 23, 23, 23, 23, 23, 23, 24, 24, 24, 24, 24, 24, 25, 25, 25, 25, 25, 25, 25, 26, 26, 26, 26, 26, 26, 26, 26, 27, 27, 27, 27, 27, 27, 27, 27, 27, 27, 28, 28, 28, 28, 28, 28, 28, 28, 28, 28, 29, 29, 29, 29, 29, 29, 29, 29, 29, 29, 29, 29, 30, 30, 30, 30, 30, 30, 30, 30, 30, 30, 30, 30, 30, 30, 31, 31, 31, 31, 31, 31, 31, 31, 31, 31, 31, 31, 31, 31, 31};

__device__ __forceinline__ float bf2f(bf16_t u) { return __uint_as_float((unsigned)u << 16); }
__device__ __forceinline__ float bflo(unsigned x) { return __uint_as_float(x << 16); }
__device__ __forceinline__ float bfhi(unsigned x) { return __uint_as_float(x & 0xffff0000u); }
typedef float f32x2_t __attribute__((ext_vector_type(2))); typedef __bf16 bf16x2_t __attribute__((ext_vector_type(2)));
__device__ __forceinline__ unsigned pk2(float lo, float hi) { f32x2_t v = {lo, hi}; bf16x2_t b = __builtin_convertvector(v, bf16x2_t); return __builtin_bit_cast(unsigned, b); }
__device__ __forceinline__ unsigned f2bf(float f) { return pk2(f, 0.f) & 0xffffu; }
__device__ __forceinline__ float wave_sum(float v) {
#pragma unroll
    for (int o = 1; o < 64; o <<= 1) v += __shfl_xor(v, o);
    return v;
}
__device__ __forceinline__ float wave_max(float v) {
#pragma unroll
    for (int o = 1; o < 64; o <<= 1) v = fmaxf(v, __shfl_xor(v, o));
    return v;
}
__device__ __forceinline__ float wave_incl_scan(float x, int lane) {
#pragma unroll
    for (int o = 1; o < 64; o <<= 1) { const float y = __shfl_up(x, o); if (lane >= o) x += y; }
    return x;
}
__device__ __forceinline__ float softplusf(float z) { return fmaxf(z, 0.f) + __logf(1.0f + __expf(-fabsf(z))); }
#define LDS_WAIT() asm volatile("s_waitcnt lgkmcnt(0)" ::: "memory")

namespace pg8 {
template <int ACT> struct EpiScale {
    static constexpr bool PERM = true, AFTER_DRAIN = false;
    bf16_t* O; int ldc; const float* rowss;
    __device__ __forceinline__ void operator()(const f32x4 (&acc)[2][2][4][2], const Unit& u, int wr, int wc, int fr, int fq) const {
        const int row0 = u.pm * BM + wr * 64 + fr, col0 = u.pn * BM + wc * 32 + 8 * fq;
#pragma unroll
        for (int ai = 0; ai < 2; ++ai)
#pragma unroll
            for (int m = 0; m < 4; ++m) {
                const int row = row0 + ai * HALF + m * 16;
                const f32x4* pp = (const f32x4*)(rowss + (size_t)row * 32 + fq * 8);
                const f32x4 pa = pp[0], pb = pp[1];
                float s = ((pa[0] + pa[1]) + (pa[2] + pa[3])) + ((pb[0] + pb[1]) + (pb[2] + pb[3]));
                s += __shfl_xor(s, 16); s += __shfl_xor(s, 32);
                const float rstd = rsqrtf(s * (1.0f / 2048.0f) + 1e-6f);
                bf16_t* rowp = O + (size_t)row * ldc + col0;
#pragma unroll
                for (int bj = 0; bj < 2; ++bj) {
                    f32x4 v0 = acc[ai][bj][m][0] * rstd, v1 = acc[ai][bj][m][1] * rstd;
                    if (ACT == 1) {
#pragma unroll
                        for (int e = 0; e < 4; ++e) { const float a = fmaxf(v0[e], 0.f), b = fmaxf(v1[e], 0.f); v0[e] = a * a; v1[e] = b * b; }
                    }
                    u32x4 w; w.x = cvt_pk_bf16(v0[0], v0[1]); w.y = cvt_pk_bf16(v0[2], v0[3]); w.z = cvt_pk_bf16(v1[0], v1[1]); w.w = cvt_pk_bf16(v1[2], v1[3]);
                    *(u32x4*)(rowp + bj * HALF) = w;
                }
            }
    }
};
struct EpiResid {
    static constexpr bool PERM = true, AFTER_DRAIN = false;
    bf16_t* xb; float* rowss;
    __device__ __forceinline__ void operator()(const f32x4 (&acc)[2][2][4][2], const Unit& u, int wr, int wc, int fr, int fq) const {
        const int row0 = u.pm * BM + wr * 64 + fr, col0 = u.pn * BM + wc * 32 + 8 * fq;
#pragma unroll
        for (int ai = 0; ai < 2; ++ai)
#pragma unroll
            for (int m = 0; m < 4; ++m) {
                const int row = row0 + ai * HALF + m * 16;
                const size_t off = (size_t)row * 2048 + col0;
                float ss = 0.f;
#pragma unroll
                for (int bj = 0; bj < 2; ++bj) {
                    const u32x4 ob = *(const u32x4*)(xb + off + bj * HALF);
                    f32x4 o0 = (f32x4){__uint_as_float(ob.x << 16), __uint_as_float(ob.x & 0xffff0000u), __uint_as_float(ob.y << 16), __uint_as_float(ob.y & 0xffff0000u)};
                    f32x4 o1 = (f32x4){__uint_as_float(ob.z << 16), __uint_as_float(ob.z & 0xffff0000u), __uint_as_float(ob.w << 16), __uint_as_float(ob.w & 0xffff0000u)};
                    o0 += acc[ai][bj][m][0]; o1 += acc[ai][bj][m][1];
                    ss += ((o0[0] * o0[0] + o0[1] * o0[1]) + (o0[2] * o0[2] + o0[3] * o0[3])) + ((o1[0] * o1[0] + o1[1] * o1[1]) + (o1[2] * o1[2] + o1[3] * o1[3]));
                    u32x4 w; w.x = cvt_pk_bf16(o0[0], o0[1]); w.y = cvt_pk_bf16(o0[2], o0[3]); w.z = cvt_pk_bf16(o1[0], o1[1]); w.w = cvt_pk_bf16(o1[2], o1[3]);
                    *(u32x4*)(xb + off + bj * HALF) = w;
                }
                ss += __shfl_xor(ss, 16); ss += __shfl_xor(ss, 32);
                if (fq == 0) rowss[(size_t)row * 32 + u.pn * 4 + wc] = ss;
            }
    }
};
}


typedef short bf16x8 __attribute__((ext_vector_type(8)));
typedef short s16x4 __attribute__((ext_vector_type(4)));
__device__ __forceinline__ f32x4 mfma16(bf16x8 a, bf16x8 b, f32x4 c) { return __builtin_amdgcn_mfma_f32_16x16x32_bf16(a, b, c, 0, 0, 0); }
__device__ __forceinline__ bf16x8 lds_frag_row(const LAS unsigned char* base, int stride, int r0, int k0, int lane) {
    return *(const LAS bf16x8*)(base + (r0 + (lane & 15)) * stride + (k0 + 8 * (lane >> 4)) * 2);
}
__device__ __forceinline__ bf16x8 lds_frag_tr(const LAS unsigned char* base, int stride, int k0, int c0, int lane) {
    const int g = lane >> 4, i = lane & 15;
    const LAS unsigned char* p = base + (k0 + 8 * g + (i >> 2)) * stride + (c0 + 4 * (i & 3)) * 2;
    const s16x4 lo = __builtin_bit_cast(s16x4, __builtin_amdgcn_ds_read_tr16_b64_v4i16((LAS s16x4*)p));
    const s16x4 hi = __builtin_bit_cast(s16x4, __builtin_amdgcn_ds_read_tr16_b64_v4i16((LAS s16x4*)(p + 4 * stride)));
    return (bf16x8){lo[0], lo[1], lo[2], lo[3], hi[0], hi[1], hi[2], hi[3]};
}

__device__ __forceinline__ bf16x8 lds_frag_trp(const LAS unsigned char* base, int stride, int k0, int c0, int p, int lane) {
    const int g = lane >> 4, i = lane & 15;
    const LAS unsigned char* q = base + (k0 + 8 * g + (i >> 2)) * stride + (c0 + 8 * (i & 3) + 4 * p) * 2;
    const s16x4 lo = __builtin_bit_cast(s16x4, __builtin_amdgcn_ds_read_tr16_b64_v4i16((LAS s16x4*)q));
    const s16x4 hi = __builtin_bit_cast(s16x4, __builtin_amdgcn_ds_read_tr16_b64_v4i16((LAS s16x4*)(q + 4 * stride)));
    return (bf16x8){lo[0], lo[1], lo[2], lo[3], hi[0], hi[1], hi[2], hi[3]};
}
__device__ __forceinline__ u32x4 pack8(const f32x4 a, const f32x4 c) { return (u32x4){pk2(a[0], a[1]), pk2(a[2], a[3]), pk2(c[0], c[1]), pk2(c[2], c[3])}; }

constexpr int GL_LG = 0, GL_QD = 24832, GL_KI = 38144, GL_KE = 51456, GL_VS = 64768, GL_SC = 90368, GL_BLR = 99584, GL_GW = 103680, GL_BL = 109824;
__device__ __forceinline__ void gla_local_item(LAS unsigned char* lds, const bf16_t* __restrict__ proj, const float* __restrict__ gwt  , const float* __restrict__ gbs  ,
                                               bf16_t* __restrict__ Ob, float* __restrict__ dstate, float* __restrict__ decay, bf16_t* __restrict__ qdec, int n, int h, int tid) {
    const int lane = tid & 63, wave = __builtin_amdgcn_readfirstlane(tid >> 6), g4 = lane >> 4, l15 = lane & 15;
    const int t0 = 64 * n;
    LAS float* lg = (LAS float*)(lds + GL_LG); LAS float* bl = (LAS float*)(lds + GL_BL);
    if (tid < 256) {
        const int row = tid >> 2, q = tid & 3;
        u32x4 v = (u32x4){0u, 0u, 0u, 0u};
        if (q < 2) v = *(const u32x4*)(proj + (size_t)(t0 + row) * PROJ_P + C_LR + 8 * q);
        *(LAS u32x4*)(lds + GL_BLR + row * 64 + q * 16) = v;
    }
    for (int i = tid; i < 96 * 32; i += NTHREADS) { const int c = i >> 5, r = i & 31; *(LAS bf16_t*)(lds + GL_GW + i * 2) = (bf16_t)((r < 16) ? f2bf(gwt[r * 384 + h * 96 + c]) : 0u); }
#pragma unroll
    for (int i = 0; i < 3; ++i) {
        const int id = tid + NTHREADS * i, row = id / 24, ch = id % 24;
        const u32x4 v = *(const u32x4*)(proj + (size_t)(t0 + row) * PROJ_P + C_BV + h * 192 + 8 * ch);
        *(LAS u32x4*)(lds + GL_VS + row * 400 + ch * 16) = v;
    }
    __syncthreads();
    {
        const int rt = wave >> 1;
        const bf16x8 a = lds_frag_row(lds + GL_BLR, 64, 16 * rt, 0, lane);
#pragma unroll
        for (int c = 0; c < 3; ++c) {
            const int ct = 3 * (wave & 1) + c;
            const bf16x8 bfr = lds_frag_row(lds + GL_GW, 64, 16 * ct, 0, lane);
            const f32x4 acc = mfma16(a, bfr, (f32x4){0.f, 0.f, 0.f, 0.f});
            const int k = 16 * ct + l15; const float gb = gbs[h * 96 + k];
#pragma unroll
            for (int i = 0; i < 4; ++i) {
                const float gp = acc[i] + gb;
                const float ls = fminf(gp, 0.f) - __logf(1.0f + __expf(-fabsf(gp)));
                lg[(16 * rt + 4 * g4 + i) * 97 + k] = fmaxf(ls * (1.0f / 16.0f), -1.0f);
            }
        }
    }
    __syncthreads();
    if (tid < 384) {
        const int k = tid >> 2, part = tid & 3;
        float run = 0.f;
#pragma unroll
        for (int i = 0; i < 16; ++i) { run += lg[(16 * part + i) * 97 + k]; lg[(16 * part + i) * 97 + k] = run; }
        const float o1 = __shfl_up(run, 1), o2 = __shfl_up(run, 2), o3 = __shfl_up(run, 3);
        const float off = (part >= 1 ? o1 : 0.f) + (part >= 2 ? o2 : 0.f) + (part >= 3 ? o3 : 0.f);
#pragma unroll
        for (int i = 0; i < 16; ++i) lg[(16 * part + i) * 97 + k] += off;
        if (part == 3) bl[k] = run + off;
    }
    __syncthreads();
#pragma unroll
    for (int it = 0; it < 3; ++it) {
        const int id = tid + NTHREADS * it, t = id / 24, k4 = (id % 24) * 4;
        const bf16_t* row = proj + (size_t)(t0 + t) * PROJ_P + h * 96 + k4;
        const u32x2 qv = *(const u32x2*)(row + C_BQ), kv = *(const u32x2*)(row + C_BK);
        const float q[4] = {bflo(qv.x), bfhi(qv.x), bflo(qv.y), bfhi(qv.y)}, kk[4] = {bflo(kv.x), bfhi(kv.x), bflo(kv.y), bfhi(kv.y)};
        float qd[4], ki[4], ke[4];
#pragma unroll
        for (int e = 0; e < 4; ++e) {
            const float bb = lg[t * 97 + k4 + e];
            qd[e] = q[e] * 0.10206207261596577f * __expf(bb); ki[e] = kk[e] * __expf(-bb); ke[e] = kk[e] * __expf(bl[k4 + e] - bb);
        }
        const u32x2 qdp = (u32x2){pk2(qd[0], qd[1]), pk2(qd[2], qd[3])};
        *(LAS u32x2*)(lds + GL_QD + t * 208 + k4 * 2) = qdp;
        *(LAS u32x2*)(lds + GL_KI + t * 208 + k4 * 2) = (u32x2){pk2(ki[0], ki[1]), pk2(ki[2], ki[3])};
        *(LAS u32x2*)(lds + GL_KE + t * 208 + k4 * 2) = (u32x2){pk2(ke[0], ke[1]), pk2(ke[2], ke[3])};
        *(u32x2*)(qdec + (size_t)(t0 + t) * 384 + h * 96 + k4) = qdp;
    }
    if (tid < 96) decay[(n * 4 + h) * 96 + tid] = __expf(bl[tid]);
    __syncthreads();
    {
        const int rt = wave >> 1;
        f32x4 acc[2] = {(f32x4){0.f, 0.f, 0.f, 0.f}, (f32x4){0.f, 0.f, 0.f, 0.f}};
#pragma unroll
        for (int ks = 0; ks < 3; ++ks) {
            const bf16x8 qf = lds_frag_row(lds + GL_QD, 208, 16 * rt, 32 * ks, lane);
#pragma unroll
            for (int c = 0; c < 2; ++c) { const bf16x8 kf = lds_frag_row(lds + GL_KI, 208, 16 * (2 * (wave & 1) + c), 32 * ks, lane); acc[c] = mfma16(kf, qf, acc[c]); }
        }
        const int t = 16 * rt + l15;
#pragma unroll
        for (int c = 0; c < 2; ++c) {
            const int s = 16 * (2 * (wave & 1) + c) + 4 * g4;
            const float v0 = (s + 0 <= t) ? acc[c][0] : 0.f, v1 = (s + 1 <= t) ? acc[c][1] : 0.f, v2 = (s + 2 <= t) ? acc[c][2] : 0.f, v3 = (s + 3 <= t) ? acc[c][3] : 0.f;
            *(LAS u32x2*)(lds + GL_SC + t * 144 + s * 2) = (u32x2){pk2(v0, v1), pk2(v2, v3)};
        }
    }
    __syncthreads();
    {
        const int rt = wave >> 1;
        const bf16x8 s0 = lds_frag_row(lds + GL_SC, 144, 16 * rt, 0, lane), s1 = lds_frag_row(lds + GL_SC, 144, 16 * rt, 32, lane);
#pragma unroll
        for (int c = 0; c < 3; ++c) {
            const int cp = 3 * (wave & 1) + c;
            f32x4 acc[2];
#pragma unroll
            for (int pp = 0; pp < 2; ++pp) {
                const bf16x8 v0 = lds_frag_trp(lds + GL_VS, 400, 0, 32 * cp, pp, lane), v1 = lds_frag_trp(lds + GL_VS, 400, 32, 32 * cp, pp, lane);
                acc[pp] = mfma16(v0, s0, (f32x4){0.f, 0.f, 0.f, 0.f}); acc[pp] = mfma16(v1, s1, acc[pp]);
            }
            *(u32x4*)(Ob + (size_t)(t0 + 16 * rt + l15) * 768 + h * 192 + 32 * cp + 8 * g4) = pack8(acc[0], acc[1]);
        }
#pragma unroll
        for (int c = 0; c < 9; ++c) {
            const int T = wave * 9 + c, kt = T / 12, ct = T % 12;
            const bf16x8 a0 = lds_frag_tr(lds + GL_KE, 208, 0, 16 * kt, lane), a1 = lds_frag_tr(lds + GL_KE, 208, 32, 16 * kt, lane);
            const bf16x8 b0 = lds_frag_tr(lds + GL_VS, 400, 0, 16 * ct, lane), b1 = lds_frag_tr(lds + GL_VS, 400, 32, 16 * ct, lane);
            f32x4 acc = mfma16(a0, b0, (f32x4){0.f, 0.f, 0.f, 0.f}); acc = mfma16(a1, b1, acc);
            *(f32x4*)(dstate + ((size_t)(n * 4 + h) * 192 + 16 * ct + l15) * 96 + 16 * kt + 4 * g4) = acc;
        }
    }
    __syncthreads();
}
__device__ __forceinline__ void gla_scan_elem(const float* __restrict__ dstate, const float* __restrict__ decay, bf16_t* __restrict__ sprev, int e) {
    const int h = e / 18432, dk = e % 96;
    float S = 0.f;
    for (int n0 = 0; n0 < 128; n0 += 16) {
        float ds[16], dc[16];
#pragma unroll
        for (int u = 0; u < 16; ++u) { ds[u] = dstate[(size_t)(n0 + u) * 73728 + e]; dc[u] = decay[((n0 + u) * 4 + h) * 96 + dk]; }
#pragma unroll
        for (int u = 0; u < 16; ++u) { sprev[(size_t)(n0 + u) * 73728 + e] = (bf16_t)f2bf(S); S = dc[u] * S + ds[u]; }
    }
}
__device__ __forceinline__ void gla_out_task(const bf16_t* __restrict__ proj, const bf16_t* __restrict__ qdec, const bf16_t* __restrict__ sprev, const bf16_t* __restrict__ Ob,
                                             const float* __restrict__ gB, bf16_t* __restrict__ mixed, int n, int h, int rt, int lane) {
    const int g4 = lane >> 4, l15 = lane & 15;
    const int t = 64 * n + 16 * rt + l15;
    bf16x8 qf[3];
#pragma unroll
    for (int ks = 0; ks < 3; ++ks) qf[ks] = *(const bf16x8*)(qdec + (size_t)t * 384 + h * 96 + 32 * ks + 8 * g4);
    f32x4 o[6][2]; float ss = 0.f;
#pragma unroll
    for (int cp = 0; cp < 6; ++cp) {
        const u32x4 ow = *(const u32x4*)(Ob + (size_t)t * 768 + h * 192 + 32 * cp + 8 * g4);
        o[cp][0] = (f32x4){bflo(ow.x), bfhi(ow.x), bflo(ow.y), bfhi(ow.y)}; o[cp][1] = (f32x4){bflo(ow.z), bfhi(ow.z), bflo(ow.w), bfhi(ow.w)};
#pragma unroll
        for (int pp = 0; pp < 2; ++pp) {
            const int dvrow = 32 * cp + 8 * (l15 >> 2) + 4 * pp + (l15 & 3);
            const bf16_t* sp = sprev + ((size_t)(n * 4 + h) * 192 + dvrow) * 96 + 8 * g4;
#pragma unroll
            for (int ks = 0; ks < 3; ++ks) o[cp][pp] = mfma16(*(const bf16x8*)(sp + 32 * ks), qf[ks], o[cp][pp]);
            ss += (o[cp][pp][0] * o[cp][pp][0] + o[cp][pp][1] * o[cp][pp][1]) + (o[cp][pp][2] * o[cp][pp][2] + o[cp][pp][3] * o[cp][pp][3]);
        }
    }
    ss += __shfl_xor(ss, 16); ss += __shfl_xor(ss, 32);
    const float r = rsqrtf(ss * (1.0f / 192.0f) + RMS_EPS);
#pragma unroll
    for (int cp = 0; cp < 6; ++cp) {
        const int dv = 32 * cp + 8 * g4;
        const f32x4 g0 = *(const f32x4*)(gB + dv), g1 = *(const f32x4*)(gB + dv + 4);
        const u32x4 bw = *(const u32x4*)(proj + (size_t)t * PROJ_P + C_BR + h * 192 + dv);
        const float br[8] = {bflo(bw.x), bfhi(bw.x), bflo(bw.y), bfhi(bw.y), bflo(bw.z), bfhi(bw.z), bflo(bw.w), bfhi(bw.w)};
        f32x4 y0, y1;
#pragma unroll
        for (int i = 0; i < 4; ++i) { y0[i] = o[cp][0][i] * r * g0[i] * (br[i] / (1.0f + __expf(-br[i]))); y1[i] = o[cp][1][i] * r * g1[i] * (br[4 + i] / (1.0f + __expf(-br[4 + i]))); }
        *(u32x4*)(mixed + (size_t)t * 2048 + 768 + h * 192 + dv) = pack8(y0, y1);
    }
}
__device__ __forceinline__ void norm_ac_row(const bf16_t* __restrict__ Oa, const bf16_t* __restrict__ Oc, const float* __restrict__ gA, const float* __restrict__ gC, bf16_t* __restrict__ mixed, int t, int lane) {
    bf16_t* mrow = mixed + (size_t)t * 2048;
    const u32x2* pa = (const u32x2*)(Oa + (size_t)t * 768) + lane; const u32x2* pc = (const u32x2*)(Oc + (size_t)t * 512) + lane;
    f32x4 a[3], c[2]; float sa = 0.f, sc = 0.f;
#pragma unroll
    for (int i = 0; i < 3; ++i) { const u32x2 w = pa[64 * i]; a[i] = (f32x4){bflo(w.x), bfhi(w.x), bflo(w.y), bfhi(w.y)}; sa += (a[i][0] * a[i][0] + a[i][1] * a[i][1]) + (a[i][2] * a[i][2] + a[i][3] * a[i][3]); }
#pragma unroll
    for (int i = 0; i < 2; ++i) { const u32x2 w = pc[64 * i]; c[i] = (f32x4){bflo(w.x), bfhi(w.x), bflo(w.y), bfhi(w.y)}; sc += (c[i][0] * c[i][0] + c[i][1] * c[i][1]) + (c[i][2] * c[i][2] + c[i][3] * c[i][3]); }
    const float ra = rsqrtf(wave_sum(sa) * (1.0f / 768.0f) + RMS_EPS), rc = rsqrtf(wave_sum(sc) * (1.0f / 512.0f) + RMS_EPS);
#pragma unroll
    for (int i = 0; i < 3; ++i) { const f32x4 g = ((const f32x4*)gA)[lane + 64 * i]; const f32x4 y = a[i] * ra * g; ((u32x2*)mrow)[lane + 64 * i] = (u32x2){pk2(y[0], y[1]), pk2(y[2], y[3])}; }
#pragma unroll
    for (int i = 0; i < 2; ++i) { const f32x4 g = ((const f32x4*)gC)[lane + 64 * i]; const f32x4 y = c[i] * rc * g; ((u32x2*)(mrow + 1536))[lane + 64 * i] = (u32x2){pk2(y[0], y[1]), pk2(y[2], y[3])}; }
}


constexpr int SB2_QS = 0, SB2_KV = 18432, SB2_KVB = 18432, SB2_FL = SB2_KV + 2 * SB2_KVB;
__device__ __forceinline__ bf16x8 lds_frag_tr2(const LAS unsigned char* base, int stride, int ra, int rb, int c0, int pp, int lane) {
    const int i = lane & 15;
    const LAS unsigned char* p = base + (i >> 2) * stride + (c0 + 8 * (i & 3) + 4 * pp) * 2;
    const s16x4 lo = __builtin_bit_cast(s16x4, __builtin_amdgcn_ds_read_tr16_b64_v4i16((LAS s16x4*)(p + ra * stride)));
    const s16x4 hi = __builtin_bit_cast(s16x4, __builtin_amdgcn_ds_read_tr16_b64_v4i16((LAS s16x4*)(p + rb * stride)));
    return (bf16x8){lo[0], lo[1], lo[2], lo[3], hi[0], hi[1], hi[2], hi[3]};
}
template <bool DIAG> __device__ __forceinline__ void sb_step(const LAS unsigned char* KV, const bf16x8 qf0, const bf16x8 qf1, f32x4 (&oacc)[4], float& R, int s0, int t, int lane) {
    const int g4 = lane >> 4;
    constexpr float SC2 = 0.125f * 1.4426950408889634f;
    float zz[4][4], cc[4][4], T[4];
#pragma unroll
    for (int ct = 0; ct < 4; ++ct) {
        const bf16x8 k0 = lds_frag_row(KV, 144, 16 * ct, 0, lane), k1 = lds_frag_row(KV, 144, 16 * ct, 32, lane);
        f32x4 z = mfma16(k0, qf0, (f32x4){0.f, 0.f, 0.f, 0.f}); z = mfma16(k1, qf1, z);
        float run = 0.f;
#pragma unroll
        for (int i = 3; i >= 0; --i) {
            const float z2 = z[i] * SC2;
            float L = -(fmaxf(z2, 0.f) + __builtin_amdgcn_logf(1.0f + __builtin_amdgcn_exp2f(-fabsf(z2))));
            if (DIAG) { if (!(s0 + 16 * ct + 4 * g4 + i < t)) L = 0.f; }
            run += L; zz[ct][i] = z2; cc[ct][i] = run;
        }
        T[ct] = run;
    }
    float base[4], H = 0.f;
#pragma unroll
    for (int ct = 3; ct >= 0; --ct) {
        const float x1 = __shfl_xor(T[ct], 16), x2 = __shfl_xor(T[ct], 32), x3 = __shfl_xor(x1, 32);
        const float off = (((g4 ^ 1) > g4) ? x1 : 0.f) + (((g4 ^ 2) > g4) ? x2 : 0.f) + (((g4 ^ 3) > g4) ? x3 : 0.f);
        base[ct] = R + H + off;
        H += (T[ct] + x1) + (x2 + x3);
    }
    R += H;
    unsigned pw[4][2];
#pragma unroll
    for (int ct = 0; ct < 4; ++ct) {
        float w[4];
#pragma unroll
        for (int i = 0; i < 4; ++i) {
            w[i] = __builtin_amdgcn_exp2f(zz[ct][i] + cc[ct][i] + base[ct]);
            if (DIAG) { if (!(s0 + 16 * ct + 4 * g4 + i < t)) w[i] = 0.f; }
        }
        pw[ct][0] = pk2(w[0], w[1]); pw[ct][1] = pk2(w[2], w[3]);
    }
#pragma unroll
    for (int ks = 0; ks < 2; ++ks) {
        const u32x4 pu = (u32x4){pw[2 * ks][0], pw[2 * ks][1], pw[2 * ks + 1][0], pw[2 * ks + 1][1]};
        const bf16x8 pf = __builtin_bit_cast(bf16x8, pu);
#pragma unroll
        for (int d = 0; d < 4; ++d) {
            const bf16x8 vf = lds_frag_tr2(KV + 9216, 144, 32 * ks + 4 * g4, 32 * ks + 16 + 4 * g4, 32 * (d >> 1), d & 1, lane);
            oacc[d] = mfma16(vf, pf, oacc[d]);
        }
    }
}
__device__ __forceinline__ void sb_item2(LAS unsigned char* lds, const bf16_t* __restrict__ proj, bf16_t* __restrict__ Oc, int h, int qb, int tid) {
    const int lane = tid & 63, wave = __builtin_amdgcn_readfirstlane(tid >> 6), g4 = lane >> 4, l15 = lane & 15;
    const int q0 = 128 * qb;
#pragma unroll
    for (int i = 0; i < 2; ++i) {
        const int id = tid + NTHREADS * i, row = id >> 3, ch = id & 7;
        *(LAS u32x4*)(lds + SB2_QS + row * 144 + ch * 16) = *(const u32x4*)(proj + (size_t)(q0 + row) * PROJ_P + C_CQ + h * 64 + 8 * ch);
    }
    const int srow = tid >> 3, sch = tid & 7;
    const bf16_t* kvsrc = proj + (size_t)srow * PROJ_P + h * 64 + 8 * sch;
    u32x4 kreg = *(const u32x4*)(kvsrc + (size_t)(64 * (2 * qb + 1)) * PROJ_P + C_CK), vreg = *(const u32x4*)(kvsrc + (size_t)(64 * (2 * qb + 1)) * PROJ_P + C_CV);
    __syncthreads();
    const bf16x8 qf0 = lds_frag_row(lds + SB2_QS, 144, 16 * wave, 0, lane), qf1 = lds_frag_row(lds + SB2_QS, 144, 16 * wave, 32, lane);
    f32x4 oacc[4];
#pragma unroll
    for (int d = 0; d < 4; ++d) oacc[d] = (f32x4){0.f, 0.f, 0.f, 0.f};
    float R = 0.f;
    const int t = q0 + 16 * wave + l15;
    LAS int* FL = (LAS int*)(lds + SB2_FL);
    int bsel = 0;
    for (int kt = 2 * qb + 1; kt >= 0; --kt, bsel ^= 1) {
        LAS unsigned char* KV = lds + SB2_KV + bsel * SB2_KVB;
        *(LAS u32x4*)(KV + srow * 144 + sch * 16) = kreg;
        *(LAS u32x4*)(KV + 9216 + srow * 144 + sch * 16) = vreg;
        if (kt > 0) { kreg = *(const u32x4*)(kvsrc + (size_t)(64 * (kt - 1)) * PROJ_P + C_CK); vreg = *(const u32x4*)(kvsrc + (size_t)(64 * (kt - 1)) * PROJ_P + C_CV); }
        const int alld = __all(R < -152.0f);
        if (lane == 0) FL[bsel * 8 + wave] = alld;
        __syncthreads();
        bool done = true;
#pragma unroll
        for (int w = 0; w < 8; ++w) done = done && (FL[bsel * 8 + w] != 0);
        if (done) break;
        const int s0 = 64 * kt;
        if (s0 >= q0 + 16 * wave + 16) continue;
        if (kt >= 2 * qb) sb_step<true>(KV, qf0, qf1, oacc, R, s0, t, lane);
        else sb_step<false>(KV, qf0, qf1, oacc, R, s0, t, lane);
    }
#pragma unroll
    for (int dp = 0; dp < 2; ++dp) *(u32x4*)(Oc + (size_t)t * 512 + h * 64 + 32 * dp + 8 * g4) = pack8(oacc[2 * dp], oacc[2 * dp + 1]);
    __syncthreads();
}


constexpr int SW2_KS = 0, SW2_VS = 36864, SW2_BT = 76032;
template <bool N0> __device__ __forceinline__ void swa_head(const LAS unsigned char* lds, const bf16x8 qf0, const bf16x8 qf1, float sink2, int g, int wave, int lane, f32x4 (&o)[4], float& linv) {
    const int g4 = lane >> 4, l15 = lane & 15;
    constexpr float SC2 = 0.125f * 1.4426950408889634f;
    const LAS float* bt = (const LAS float*)(lds + SW2_BT) + g * 160 + (128 + 16 + l15 - 4 * g4);
    f32x4 st[9];
    float mt = -3.0e38f;
#pragma unroll
    for (int jt = 0; jt < 9; ++jt) {
        const bf16x8 k0 = lds_frag_row(lds + SW2_KS, 144, 16 * (wave + jt), 0, lane), k1 = lds_frag_row(lds + SW2_KS, 144, 16 * (wave + jt), 32, lane);
        f32x4 c = (f32x4){bt[-16 * jt], bt[-16 * jt - 1], bt[-16 * jt - 2], bt[-16 * jt - 3]};
        if (N0) {
#pragma unroll
            for (int i = 0; i < 4; ++i) if (16 * (wave + jt) + 4 * g4 + i < 128) c[i] = -1e30f;
        }
        c = mfma16(k0, qf0, c); c = mfma16(k1, qf1, c);
        st[jt] = c;
        mt = fmaxf(mt, fmaxf(fmaxf(c[0], c[1]), fmaxf(c[2], c[3])));
    }
    mt = fmaxf(mt, __shfl_xor(mt, 16)); mt = fmaxf(mt, __shfl_xor(mt, 32));
    const float m = fmaxf(mt * SC2, sink2);
    float l = 0.f;
    unsigned pw[10][2];
#pragma unroll
    for (int jt = 0; jt < 9; ++jt) {
        float e[4];
#pragma unroll
        for (int i = 0; i < 4; ++i) { e[i] = __builtin_amdgcn_exp2f(st[jt][i] * SC2 - m); l += e[i]; }
        pw[jt][0] = pk2(e[0], e[1]); pw[jt][1] = pk2(e[2], e[3]);
    }
    pw[9][0] = 0u; pw[9][1] = 0u;
    l += __shfl_xor(l, 16); l += __shfl_xor(l, 32);
    linv = 1.0f / (l + __builtin_amdgcn_exp2f(sink2 - m));
#pragma unroll
    for (int d = 0; d < 4; ++d) o[d] = (f32x4){0.f, 0.f, 0.f, 0.f};
#pragma unroll
    for (int c = 0; c < 5; ++c) {
        const u32x4 pu = (u32x4){pw[2 * c][0], pw[2 * c][1], pw[2 * c + 1][0], pw[2 * c + 1][1]};
        const bf16x8 pf = __builtin_bit_cast(bf16x8, pu);
        const int ra = 16 * (wave + 2 * c) + 4 * g4;
#pragma unroll
        for (int d = 0; d < 4; ++d) { const bf16x8 vf = lds_frag_tr2(lds + SW2_VS, 144, ra, ra + 16, 32 * (d >> 1), d & 1, lane); o[d] = mfma16(vf, pf, o[d]); }
    }
}
__device__ __forceinline__ void swa_item2(LAS unsigned char* lds, const bf16_t* __restrict__ proj, const float* __restrict__ sinks, const float* __restrict__ relb, bf16_t* __restrict__ Oa, int n, int hk, int tid) {
    const int lane = tid & 63, wave = __builtin_amdgcn_readfirstlane(tid >> 6), g4 = lane >> 4, l15 = lane & 15;
#pragma unroll
    for (int i = 0; i < 4; ++i) {
        const int id = tid + NTHREADS * i, row = id >> 3, ch = id & 7, s = 128 * (n - 1) + row;
        u32x4 kv = (u32x4){0u, 0u, 0u, 0u}, vv = (u32x4){0u, 0u, 0u, 0u};
        if (s >= 0) { const bf16_t* src = proj + (size_t)s * PROJ_P + hk * 64 + 8 * ch; kv = *(const u32x4*)(src + C_AK); vv = *(const u32x4*)(src + C_AV); }
        *(LAS u32x4*)(lds + SW2_KS + row * 144 + ch * 16) = kv;
        *(LAS u32x4*)(lds + SW2_VS + row * 144 + ch * 16) = vv;
    }
    if (tid < 128) { const int row = 256 + (tid >> 3), ch = tid & 7; *(LAS u32x4*)(lds + SW2_VS + row * 144 + ch * 16) = (u32x4){0u, 0u, 0u, 0u}; }
    if (tid < 480) { const int g = tid / 160, e = tid % 160, dist = e - 16; ((LAS float*)(lds + SW2_BT))[tid] = (dist >= 0 && dist < 128) ? 8.0f * relb[(int)T5B[dist] * 12 + 3 * hk + g] : -1e30f; }
    __syncthreads();
    const int t = 128 * n + 16 * wave + l15;
    for (int g = 0; g < 3; ++g) {
        const int hq = 3 * hk + g;
        const bf16_t* qrow = proj + (size_t)t * PROJ_P + C_AQ + hq * 64 + 8 * g4;
        const bf16x8 qf0 = *(const bf16x8*)qrow, qf1 = *(const bf16x8*)(qrow + 32);
        const float sink2 = sinks[hq] * 1.4426950408889634f;
        f32x4 o[4]; float linv;
        if (n == 0) swa_head<true>(lds, qf0, qf1, sink2, g, wave, lane, o, linv);
        else swa_head<false>(lds, qf0, qf1, sink2, g, wave, lane, o, linv);
#pragma unroll
        for (int dp = 0; dp < 2; ++dp) *(u32x4*)(Oa + (size_t)t * 768 + hq * 64 + 32 * dp + 8 * g4) = pack8(o[2 * dp] * linv, o[2 * dp + 1] * linv);
    }
    __syncthreads();
}

struct Params { const float* in[15]; float* out; unsigned char* ws; int ph_lo, ph_hi; };

constexpr int CV_STRIDE = 528, CV_BUF = 64 * CV_STRIDE;
constexpr int CV_NWIN = 32 * 21, CV_NOUT = 32 * 8, CV_N1 = 32 * 32, CV_N2 = 128 * 8, CV_NREST = CV_NOUT + CV_N1 + CV_N2;
constexpr int CV_DEFER = 1280;
constexpr int CV_SHADOW = 0;
constexpr int CV_STG = 128 * 8;
constexpr int CV_NPL = CV_NREST - CV_DEFER - CV_STG;
constexpr int CV_NPRO = 2 * CV_NWIN + 2 * CV_NPL;
struct CvTile { const float* src; const float* gain; bf16_t* dst; int N, K, zero_from; };
__device__ __forceinline__ CvTile cv_win(const Params& p, int l, int r) {
    const int kb = r / 21, nt = r % 21;
    const int srccol = (nt < 14) ? 256 * nt : (nt < 20 ? 256 * nt + 16 : 3584);
    CvTile t; t.N = PROJ_W; t.K = DM; t.zero_from = (nt == 20) ? 16 : 256;
    t.src = p.in[2] + (size_t)l * DM * PROJ_W + (size_t)(64 * kb) * PROJ_W + srccol; t.gain = p.in[1] + l * DM + 64 * kb;
    t.dst = (bf16_t*)(p.ws + WS_WT + (size_t)l * WT_LAYER + WT_IN) + (size_t)(256 * nt) * DM + 64 * kb;
    return t;
}
__device__ __forceinline__ CvTile cv_rest(const Params& p, int l, int r) {
    CvTile t; t.zero_from = 256;
    if (r < CV_NOUT) { const int kb = r / 8, nt = r % 8; t.N = DM; t.K = DM; t.src = p.in[10] + (size_t)l * DM * DM + (size_t)(64 * kb) * DM + 256 * nt; t.gain = nullptr;
                       t.dst = (bf16_t*)(p.ws + WS_WT + (size_t)l * WT_LAYER + WT_OUT) + (size_t)(256 * nt) * DM + 64 * kb; return t; }
    r -= CV_NOUT;
    if (r < CV_N1) { const int kb = r / 32, nt = r % 32; t.N = DFF; t.K = DM; t.src = p.in[12] + (size_t)l * DM * DFF + (size_t)(64 * kb) * DFF + 256 * nt; t.gain = p.in[11] + l * DM + 64 * kb;
                     t.dst = (bf16_t*)(p.ws + WS_WT + (size_t)l * WT_LAYER + WT_1) + (size_t)(256 * nt) * DM + 64 * kb; return t; }
    r -= CV_N1;
    { const int kb = r / 8, nt = r % 8; t.N = DM; t.K = DFF; t.src = p.in[13] + (size_t)l * DFF * DM + (size_t)(64 * kb) * DM + 256 * nt; t.gain = nullptr;
      t.dst = (bf16_t*)(p.ws + WS_WT + (size_t)l * WT_LAYER + WT_2) + (size_t)(256 * nt) * DFF + 64 * kb; return t; }
}
__device__ __forceinline__ CvTile cv_make(const Params& p, int mode, int l, int idx) {
    if (mode == 1) return cv_rest(p, l, idx);
    if (mode == 3) return cv_rest(p, l, CV_NOUT + CV_N1 + idx);
    if (idx < CV_NWIN) return cv_win(p, 0, idx);
    if (idx < 2 * CV_NWIN) return cv_win(p, 1, idx - CV_NWIN);
    constexpr int NPL1 = CV_NPL > 0 ? CV_NPL : 1;
    const int j = idx - 2 * CV_NWIN, ll = j / NPL1; int r = CV_DEFER + j % NPL1;
    if (r >= CV_NOUT + CV_N1) r += CV_STG;
    return cv_rest(p, ll, r);
}
__device__ __forceinline__ void cv_load(const CvTile& t, int wave, int lane, f32x4 (&v)[8]) {
#pragma unroll
    for (int j = 0; j < 8; ++j) {
        const int k = 8 * wave + j;
        f32x4 x = (f32x4){0.f, 0.f, 0.f, 0.f};
        if (4 * lane < t.zero_from) x = *(const f32x4*)(t.src + (size_t)k * t.N + 4 * lane);
        const float g = t.gain ? t.gain[k] : 1.0f;
        v[j] = x * g;
    }
}
__device__ __forceinline__ void cv_run(LAS unsigned char* lds, const Params& p, int mode, int l, int first, int stride, int count, int tid) {
    if (count <= 0) return;
    const int lane = tid & 63, wave = __builtin_amdgcn_readfirstlane(tid >> 6);
    CvTile cur = cv_make(p, mode, l, first);
    f32x4 v[8];
    cv_load(cur, wave, lane, v);
    for (int i = 0; i < count; ++i) {
        LAS unsigned char* buf = lds + (i & 1) * CV_BUF;
#pragma unroll
        for (int j = 0; j < 8; ++j) *(LAS u32x2*)(buf + (8 * wave + j) * CV_STRIDE + 8 * lane) = (u32x2){pk2(v[j][0], v[j][1]), pk2(v[j][2], v[j][3])};
        CvTile nxt = cur;
        if (i + 1 < count) { nxt = cv_make(p, mode, l, first + (i + 1) * stride); cv_load(nxt, wave, lane, v); }
        __syncthreads();
#pragma unroll
        for (int grp = 0; grp < 2; ++grp)
#pragma unroll
            for (int kh = 0; kh < 2; ++kh) {
                const int c0 = 32 * wave + 16 * grp;
                const bf16x8 f = lds_frag_tr(buf, CV_STRIDE, 32 * kh, c0, lane);
                *(bf16x8*)(cur.dst + (size_t)(c0 + (lane & 15)) * cur.K + 32 * kh + 8 * (lane >> 4)) = f;
            }
        cur = nxt;
    }
    __syncthreads();
}

#ifndef PH_MASK
#define PH_MASK 0x1ff
#endif
#define HAS(k) (((PH_MASK) >> (k)) & 1)
#define XB_TMO      128
#define XB_XCNT(j)  (256  + 64 * (j))
#define XB_XSUB(j)  (1280 + 64 * (j))
#define XB_XGEN(j)  (2304 + 64 * (j))
#define XB_TOP      3328
#define XB_TOPGEN   3392
#define XCD_BAR_WORDS 3456
#define XB_SPIN_CAP (1u << 18)

__device__ __forceinline__ unsigned xb_ld(unsigned* p)              { return __hip_atomic_load(p, __ATOMIC_RELAXED, __HIP_MEMORY_SCOPE_AGENT); }
__device__ __forceinline__ unsigned xb_add(unsigned* p, unsigned v) { return __hip_atomic_fetch_add(p, v, __ATOMIC_RELAXED, __HIP_MEMORY_SCOPE_AGENT); }
__device__ __forceinline__ unsigned xb_xcc_id() { return (unsigned)__builtin_amdgcn_s_getreg((3 << 11) | 20) & 0xFu; }
#define XB_SPIN(cond, bar) do { unsigned _sp = 0; while (cond) { __builtin_amdgcn_s_sleep(1); \
    if ((++_sp & 255u) == 0u) { if (xb_ld(&(bar)[XB_TMO])) break; if (_sp > XB_SPIN_CAP) { atomicAdd(&(bar)[XB_TMO], 1u); break; } } } } while (0)

struct XcdBarrier {
    unsigned* bar; unsigned x;
    volatile LAS unsigned* st;
};

__device__ __forceinline__ XcdBarrier xcd_barrier_post(unsigned* bar, volatile LAS unsigned* st) {
    XcdBarrier b; b.bar = bar; b.x = xb_xcc_id(); b.st = st;
    if (threadIdx.x == 0) (void)xb_add(&bar[XB_XCNT(b.x)], 1u);
    return b;
}
__device__ __forceinline__ void xcd_barrier_complete(unsigned* bar, unsigned x, unsigned& nloc, unsigned& nx) {
    const unsigned G = gridDim.x * gridDim.y * gridDim.z;
    unsigned sum, cnt, mine, sp = 0u;
    for (;;) {
        sum = 0u; cnt = 0u; mine = 0u;
#pragma unroll
        for (unsigned j = 0; j < 16; ++j) { const unsigned c = xb_ld(&bar[XB_XCNT(j)]); sum += c; cnt += (c > 0u) ? 1u : 0u; mine = (j == x) ? c : mine; }
        if (sum == G) break;
        __builtin_amdgcn_s_sleep(1);
        if ((++sp & 255u) == 0u) { if (xb_ld(&bar[XB_TMO])) break; if (sp > XB_SPIN_CAP) { atomicAdd(&bar[XB_TMO], 1u); break; } }
    }
    nloc = mine > 0u ? mine : 1u; nx = cnt > 0u ? cnt : 1u;
}

__device__ __forceinline__ void xcd_barrier(const XcdBarrier& b) {
    asm volatile("s_waitcnt vmcnt(0)" ::: "memory");
    __syncthreads();
    if (threadIdx.x == 0) {
        unsigned* bar = b.bar;
        __builtin_amdgcn_s_waitcnt(0);
        unsigned nloc = b.st[0], nx = b.st[1];
        if (nloc == 0u) { xcd_barrier_complete(bar, b.x, nloc, nx); b.st[0] = nloc; b.st[1] = nx; }
        const unsigned old = xb_add(&bar[XB_XSUB(b.x)], 1u);
        const unsigned gen = old / nloc;
        if (old + 1u == (gen + 1u) * nloc) {
            __builtin_amdgcn_fence(__ATOMIC_RELEASE, "agent");
            asm volatile("s_waitcnt vmcnt(0)" ::: "memory");
            const unsigned og = xb_add(&bar[XB_TOP], 1u);
            const unsigned tg = og / nx;
            if (og + 1u == (tg + 1u) * nx) xb_add(&bar[XB_TOPGEN], 1u);
            else XB_SPIN(xb_ld(&bar[XB_TOPGEN]) == tg, bar);
            __builtin_amdgcn_fence(__ATOMIC_ACQUIRE, "agent");
            xb_add(&bar[XB_XGEN(b.x)], 1u);
            asm volatile("s_waitcnt vmcnt(0)" ::: "memory");
        } else {
            XB_SPIN(xb_ld(&bar[XB_XGEN(b.x)]) == gen, bar);
            __builtin_amdgcn_fence(__ATOMIC_ACQUIRE, "agent");
            asm volatile("s_waitcnt vmcnt(0)" ::: "memory");
        }
    }
    __syncthreads();
}

#define SB_XSUB(j) (4096 + 64 * (j))
#define SB_TOP     (4096 + 64 * 16)
#define SB_XGEN(j) (4096 + 64 * 17 + 64 * (j))
__device__ __forceinline__ void split_arrive(const XcdBarrier& b) {
    asm volatile("s_waitcnt vmcnt(0)" ::: "memory");
    __syncthreads();
    if (threadIdx.x == 0) {
        unsigned* bar = b.bar;
        const unsigned nloc = b.st[0], nx = b.st[1];
        const unsigned old = xb_add(&bar[SB_XSUB(b.x)], 1u);
        if ((old + 1u) % nloc == 0u) {
            __builtin_amdgcn_fence(__ATOMIC_RELEASE, "agent");
            asm volatile("s_waitcnt vmcnt(0)" ::: "memory");
            const unsigned og = xb_add(&bar[SB_TOP], 1u);
            if ((og + 1u) % nx == 0u) {
#pragma unroll
                for (unsigned j = 0; j < 16; ++j) if (xb_ld(&bar[XB_XCNT(j)]) > 0u) xb_add(&bar[SB_XGEN(j)], 1u);
            }
        }
    }
}
__device__ __forceinline__ void split_wait(const XcdBarrier& b, unsigned epoch) {
    if (threadIdx.x == 0) {
        unsigned* bar = b.bar;
        XB_SPIN(xb_ld(&bar[SB_XGEN(b.x)]) < epoch, bar);
        __builtin_amdgcn_fence(__ATOMIC_ACQUIRE, "agent");
        asm volatile("s_waitcnt vmcnt(0)" ::: "memory");
    }
    __syncthreads();
}

#ifdef PROBE_CAT
#define PROBE_DECL unsigned long long pr_last = __builtin_amdgcn_s_memrealtime(), pr_acc = 0
#define STAMP(cat) do { const unsigned long long now_ = __builtin_amdgcn_s_memrealtime(); if ((cat) == PROBE_CAT) pr_acc += now_ - pr_last; pr_last = now_; } while (0)
#else
#define PROBE_DECL do {} while (0)
#define STAMP(cat) do {} while (0)
#endif
constexpr int N_PHASES = 16;

__global__ void __launch_bounds__(NTHREADS, 2) mega(Params p) {
    extern __shared__ __attribute__((aligned(16))) unsigned char lds_raw[];
    LAS unsigned char* lds = (LAS unsigned char*)lds_raw;
    volatile LAS unsigned* bst = (volatile LAS unsigned*)(lds + LDS_BYTES - 16);
    if (threadIdx.x == 0) { bst[0] = 0u; bst[1] = 0u; }
    __syncthreads();
    const XcdBarrier bar = xcd_barrier_post((unsigned*)(p.ws + WS_CTL) + 1024, bst);
    const int G = gridDim.x;
    PROBE_DECL;
    unsigned char* ws = p.ws;
    const float* x_in = p.in[0];
    float* xres = p.out;
    bf16_t* xb = (bf16_t*)(ws + WS_XB);
    float* rowss = (float*)(ws + WS_ROWSS);
    bf16_t* proj = (bf16_t*)(ws + WS_PROJ);
    bf16_t* Oa = (bf16_t*)(ws + WS_OA); bf16_t* Ob = (bf16_t*)(ws + WS_OB); bf16_t* Oc = (bf16_t*)(ws + WS_OC);
    float* dstate = (float*)(ws + WS_DSTATE); float* decay = (float*)(ws + WS_DECAY); bf16_t* sprev = (bf16_t*)(ws + WS_SPREV); bf16_t* qdec = (bf16_t*)(ws + WS_QDEC);
    bf16_t* mixed = (bf16_t*)(ws + WS_MIXED);
    bf16_t* hid = (bf16_t*)(ws + WS_HID);
#define IN(k) (p.ph_lo <= (k) && (k) < p.ph_hi)
#define SYNC(k) do { if (IN(k) && IN((k) + 1)) xcd_barrier(bar); STAMP(1); } while (0)
#define PHASE_IDS() int tid = threadIdx.x; asm volatile("" : "+v"(tid)); const int lane = tid & 63, wave = __builtin_amdgcn_readfirstlane(tid >> 6), gw = blockIdx.x * NWAVES + wave, NGW = G * NWAVES; (void)lane; (void)gw; (void)NGW

    if (HAS(0) && IN(0)) {
        PHASE_IDS();
        {
            const int first = blockIdx.x, cnt = (first < CV_NPRO) ? (CV_NPRO - first + G - 1) / G : 0;
            cv_run(lds, p, 0, 0, first, G, cnt, tid);
        }
        if (G != 256) { for (int ll = 0; ll < DEPTH; ++ll) { const int f2 = blockIdx.x, c2 = (f2 < CV_DEFER) ? (CV_DEFER - f2 + G - 1) / G : 0, c3 = (f2 < CV_STG) ? (CV_STG - f2 + G - 1) / G : 0; cv_run(lds, p, 1, ll, f2, G, c2, tid); cv_run(lds, p, 3, ll, f2, G, c3, tid); } }
        for (int m = gw; m < SEQ; m += NGW) {
            const f32x4* xr = (const f32x4*)(x_in + (size_t)m * DM) + lane;
            f32x4 v[8]; float ss = 0.f;
#pragma unroll
            for (int j = 0; j < 8; ++j) { v[j] = xr[64 * j]; ss += (v[j][0] * v[j][0] + v[j][1] * v[j][1]) + (v[j][2] * v[j][2] + v[j][3] * v[j][3]); }
            ss = wave_sum(ss);
            u32x2* o8 = (u32x2*)(xb + (size_t)m * DM) + lane;
#pragma unroll
            for (int j = 0; j < 8; ++j) { u32x2 w; w.x = pk2(v[j][0], v[j][1]); w.y = pk2(v[j][2], v[j][3]); o8[64 * j] = w; }
            if (lane < 32) rowss[(size_t)m * 32 + lane] = (lane == 0) ? ss : 0.f;
        }
    }
    STAMP(0);
    SYNC(0);
    for (int l = 0; l < DEPTH; ++l) {
        const int pb = 1 + 7 * l;
        unsigned char* wt = ws + WS_WT + (size_t)l * WT_LAYER;
        if (HAS(1) && IN(pb + 0)) {
            pg8::Gemm g{xb, (const bf16_t*)(wt + WT_IN), SEQ, PROJ_P, DM}; pg8::StaticOrder S; S.init(SEQ, PROJ_P, G, (int)blockIdx.x);
            pg8::EpiScale<0> E{proj, PROJ_P, rowss};
            pg8::gemm_phase<pg8::EpiScale<0>, pg8::StaticOrder, true, true>(lds, g, S, E);
            if (G == 256 && blockIdx.x >= 160) {
                int tid2 = threadIdx.x; asm volatile("" : "+v"(tid2));
                { const int e = (int)blockIdx.x - 160; cv_run(lds, p, 1, l, e, 96, (CV_DEFER - e + 95) / 96, tid2); }
            }
        }
        STAMP(2);
        SYNC(pb + 0);
        if (HAS(2) && IN(pb + 1)) {
            PHASE_IDS();
            const float* gwt = p.in[5] + (size_t)l * 16 * 384; const float* gbs = p.in[6] + l * 384;
            for (int it = blockIdx.x; it < 512; it += G) gla_local_item(lds, proj, gwt, gbs, Ob, dstate, decay, qdec, it >> 2, it & 3, tid);
            STAMP(10);
            split_arrive(bar);
            const float* sinks = p.in[3] + l * 12; const float* relb = p.in[4];
            for (int it = blockIdx.x; it < 256; it += G) swa_item2(lds, proj, sinks, relb, Oa, it >> 2, it & 3, tid);
            STAMP(11);
            for (int it = blockIdx.x; it < 512; it += G) sb_item2(lds, proj, Oc, it & 7, it >> 3, tid);
            STAMP(12);
            split_wait(bar, 2u * (unsigned)l + 1u);
            STAMP(13);
            {
                const int per = (73728 + G - 1) / G, e1 = min((int)(blockIdx.x + 1) * per, 73728);
                for (int e = blockIdx.x * per + tid; e < e1; e += NTHREADS) gla_scan_elem(dstate, decay, sprev, e);
            }
            STAMP(4);
            split_arrive(bar);
            cv_run(lds, p, 2, l, (int)blockIdx.x, G, CV_SHADOW / 256, tid);
            STAMP(14);
            split_wait(bar, 2u * (unsigned)l + 2u);
            STAMP(15);
            const float* gA = p.in[8] + l * 768; const float* gB = p.in[7] + l * 192; const float* gC = p.in[9] + l * 512;
            for (int it = gw; it < 2048; it += NGW) gla_out_task(proj, qdec, sprev, Ob, gB, mixed, it >> 4, (it >> 2) & 3, it & 3, lane);
            for (int t = gw; t < SEQ; t += NGW) norm_ac_row(Oa, Oc, gA, gC, mixed, t, lane);
            STAMP(5);
        }
        SYNC(pb + 1);
        if (HAS(5) && IN(pb + 4)) {
            pg8::Gemm g{mixed, (const bf16_t*)(wt + WT_OUT), SEQ, DM, DM}; pg8::StaticOrder S; S.init(SEQ, DM, G, (int)blockIdx.x);
            pg8::EpiResid E{xb, rowss};
            pg8::gemm_phase<pg8::EpiResid, pg8::StaticOrder, true, true>(lds, g, S, E);
        }
        STAMP(6);
        SYNC(pb + 4);
        if (HAS(6) && IN(pb + 5)) {
            pg8::Gemm g{xb, (const bf16_t*)(wt + WT_1), SEQ, DFF, DM}; pg8::StaticOrder S; S.init(SEQ, DFF, G, (int)blockIdx.x);
            pg8::EpiScale<1> E{hid, DFF, rowss};
            if (G == 256 && ((blockIdx.x >> 3) & 1)) {
                int tid2 = threadIdx.x; asm volatile("" : "+v"(tid2));
                const int e = (int)(((blockIdx.x >> 4) << 3) | (blockIdx.x & 7));
                cv_run(lds, p, 3, l, e, 128, CV_STG / 128, tid2);
            }
            pg8::gemm_phase<pg8::EpiScale<1>, pg8::StaticOrder, true, true>(lds, g, S, E);
        }
        STAMP(7);
        SYNC(pb + 5);
        if (HAS(7) && IN(pb + 6)) {
            pg8::Gemm g{hid, (const bf16_t*)(wt + WT_2), SEQ, DM, DFF}; pg8::StaticOrder S; S.init(SEQ, DM, G, (int)blockIdx.x);
            pg8::EpiResid E{xb, rowss};
            pg8::gemm_phase<pg8::EpiResid, pg8::StaticOrder, true, true>(lds, g, S, E);
        }
        STAMP(8);
        SYNC(pb + 6);
    }
    if (HAS(8) && IN(N_PHASES - 1)) {
        PHASE_IDS();
        const float* gF = p.in[14];
        for (int m = gw; m < SEQ; m += NGW) {
            const float part = (lane < 32) ? rowss[(size_t)m * 32 + lane] : 0.f;
            const float rstd = rsqrtf(wave_sum(part) * (1.0f / 2048.0f) + RMS_EPS);
            const u32x2* xr = (const u32x2*)(xb + (size_t)m * DM) + lane;
            f32x4* orow = (f32x4*)(xres + (size_t)m * DM) + lane;
            const f32x4* gr = (const f32x4*)gF + lane;
#pragma unroll
            for (int j = 0; j < 8; ++j) { const u32x2 w = xr[64 * j]; const f32x4 g = gr[64 * j]; f32x4 v = (f32x4){bflo(w.x), bfhi(w.x), bflo(w.y), bfhi(w.y)}; v = v * rstd * g; orow[64 * j] = v; }
        }
    }
#ifdef PROBE_CAT
    STAMP(9);
    if (blockIdx.x == 0) { const unsigned long long t0_ = __builtin_amdgcn_s_memrealtime(); while (__builtin_amdgcn_s_memrealtime() - t0_ < 4ull * pr_acc) __builtin_amdgcn_s_sleep(8); }
#endif
}

#ifndef MK_N_LAUNCHES
#define MK_N_LAUNCHES 1
#endif
extern "C" void kernel_launch(void* const* d_in, const int* in_sizes, int n_in, void* d_out, int out_size, void* d_ws, size_t ws_size, hipStream_t stream) {
    static int grid = 0;
    if (grid == 0) {
        if (n_in != 15 || out_size != SEQ * DM || ws_size < WS_END) { fprintf(stderr, "kernel_launch: unexpected shapes (n_in %d out %d ws %zu)\n", n_in, out_size, ws_size); grid = -1; return; }
        int dev = 0, cus = 0, per_cu = 0;
        hipGetDevice(&dev);
        hipDeviceGetAttribute(&cus, hipDeviceAttributeMultiprocessorCount, dev);
        hipFuncSetAttribute((const void*)mega, hipFuncAttributeMaxDynamicSharedMemorySize, LDS_BYTES);
        hipOccupancyMaxActiveBlocksPerMultiprocessor(&per_cu, (const void*)mega, NTHREADS, LDS_BYTES);
        if (per_cu < 1) { fprintf(stderr, "kernel_launch: the occupancy query admits %d workgroups per CU for this kernel; nothing launched\n", per_cu); (void)hipGetLastError(); grid = -1; return; }
        (void)hipGetLastError();
        grid = cus * 1;
    }
    if (grid < 0) return;
    if (hipMemsetAsync((char*)d_ws + WS_CTL, 0, 65536, stream) != hipSuccess) { fprintf(stderr, "kernel_launch: memset failed\n"); return; }
    Params p{};
    for (int i = 0; i < 15; ++i) p.in[i] = (const float*)d_in[i];
    p.out = (float*)d_out; p.ws = (unsigned char*)d_ws;
    if (MK_N_LAUNCHES == 1) {
        p.ph_lo = 0; p.ph_hi = N_PHASES;
        void* args[] = {&p};
        hipError_t e = hipLaunchCooperativeKernel((const void*)mega, dim3(grid), dim3(NTHREADS), args, LDS_BYTES, stream);
        if (e != hipSuccess) fprintf(stderr, "cooperative launch failed: %s (grid %d)\n", hipGetErrorString(e), grid);
    } else {
        for (int ph = 0; ph < N_PHASES; ++ph) {
            p.ph_lo = ph; p.ph_hi = ph + 1;
            hipLaunchKernelGGL(mega, dim3(grid), dim3(NTHREADS), LDS_BYTES, stream, p);
        }
    }
}
```
